# Optimizing an MI355X kernel written in HIP

```python
import math
import jax, jax.numpy as jnp
from jax import lax
import numpy as np

D_MODEL = 1024
BATCH = 8
SEQ = 4096
DEPTH = 1

PLE_DIM = 256
SB_HEADS = 8
SB_HEAD_DIM = 64
SB_WIDTH = SB_HEADS * SB_HEAD_DIM
SB_BLOCK_Q = 128
SB_SCALE = 1.0 / math.sqrt(SB_HEAD_DIM)
ML_HEADS = 4
ML_HEAD_DIM = 128
ML_WIDTH = ML_HEADS * ML_HEAD_DIM
ML_CHUNK = 64
CONV_WIDTH = 4
D_FF = 4 * D_MODEL
RMS_EPS = 1e-6
IN_SIZES = (SB_WIDTH, SB_WIDTH, SB_WIDTH, ML_WIDTH, ML_WIDTH, ML_WIDTH, ML_WIDTH, ML_HEADS, ML_HEADS, D_MODEL, D_MODEL)
IN_COLS = sum(IN_SIZES)
IN_OFFSETS = tuple(int(v) for v in np.cumsum(IN_SIZES)[:-1])

kernel_name = "hybrid_stickbreak_mlstm_gated_block"


def rmsnorm(x, g):
    xf = x.astype(jnp.float32)
    y = xf * lax.rsqrt(jnp.mean(xf * xf, axis=-1, keepdims=True) + RMS_EPS)
    return (y * g.astype(jnp.float32)).astype(x.dtype)


def causal_depthwise_conv(u, w, b):
    c = u.shape[-1]
    y = lax.conv_general_dilated(u, w[:, None, :].astype(u.dtype), window_strides=(1,),
                                 padding=[(CONV_WIDTH - 1, 0)],
                                 dimension_numbers=('NWC', 'WIO', 'NWC'),
                                 feature_group_count=c)
    return y + b.astype(y.dtype)


def split_heads(u, n_heads):
    bsz, seq, _ = u.shape
    return u.reshape(bsz, seq, n_heads, -1).transpose(0, 2, 1, 3)


def merge_heads(u):
    bsz, nh, seq, dh = u.shape
    return u.transpose(0, 2, 1, 3).reshape(bsz, seq, nh * dh)


def stick_breaking_attention(q, k, v):
    seq = q.shape[2]
    outs = []
    for blk in range(seq // SB_BLOCK_Q):
        t0 = blk * SB_BLOCK_Q
        kv_len = t0 + SB_BLOCK_Q
        z = jnp.einsum('bhqd,bhkd->bhqk', q[:, :, t0:kv_len], k[:, :, :kv_len]) * SB_SCALE
        mask = jnp.arange(kv_len)[None, :] < (t0 + jnp.arange(SB_BLOCK_Q))[:, None]
        log_beta = jax.nn.log_sigmoid(z)
        log_keep = jnp.where(mask, log_beta - z, 0.0)
        log_after = lax.cumsum(log_keep, axis=3, reverse=True) - log_keep
        a = jnp.where(mask, jnp.exp(log_beta + log_after), 0.0)
        outs.append(jnp.einsum('bhqk,bhkd->bhqd', a, v[:, :, :kv_len]))
    return jnp.concatenate(outs, axis=2)


def mlstm_chunkwise(q, k, v, i_pre, log_f):
    bsz, nh, seq, dh = q.shape
    nc = seq // ML_CHUNK
    k = k * (dh ** -0.5)

    def to_chunks(a):
        a = a.reshape(bsz, nh, nc, ML_CHUNK, *a.shape[3:])
        return jnp.moveaxis(a, 2, 0)

    causal = jnp.tril(jnp.ones((ML_CHUNK, ML_CHUNK), dtype=bool))

    def step(carry, inp):
        c_prev, n_prev, m_prev = carry
        qc, kc, vc, ic, fc = inp
        b = jnp.cumsum(fc, axis=-1)
        d = b[..., :, None] - b[..., None, :] + ic[..., None, :]
        d = jnp.where(causal, d, -jnp.inf)
        m_inter = b + m_prev[..., None]
        m_t = jnp.maximum(m_inter, jnp.max(d, axis=-1))
        s_mat = jnp.einsum('bhtd,bhsd->bhts', qc, kc) * jnp.exp(d - m_t[..., None])
        inter = jnp.exp(m_inter - m_t)
        num = jnp.einsum('bhts,bhsd->bhtd', s_mat, vc) + inter[..., None] * jnp.einsum('bhvk,bhtk->bhtv', c_prev, qc)
        den = jnp.sum(s_mat, axis=-1) + inter * jnp.einsum('bhk,bhtk->bht', n_prev, qc)
        h = num / jnp.maximum(jnp.abs(den), jnp.exp(-m_t))[..., None]
        b_end = b[..., -1]
        g = b_end[..., None] - b + ic
        m_new = jnp.maximum(b_end + m_prev, jnp.max(g, axis=-1))
        w_s = jnp.exp(g - m_new[..., None])
        decay = jnp.exp(b_end + m_prev - m_new)
        c_new = decay[..., None, None] * c_prev + jnp.einsum('bhs,bhsv,bhsk->bhvk', w_s, vc, kc)
        n_new = decay[..., None] * n_prev + jnp.einsum('bhs,bhsk->bhk', w_s, kc)
        return (c_new, n_new, m_new), h

    init = (jnp.zeros((bsz, nh, dh, dh), jnp.float32),
            jnp.zeros((bsz, nh, dh), jnp.float32),
            jnp.zeros((bsz, nh), jnp.float32))
    xs = (to_chunks(q), to_chunks(k), to_chunks(v), to_chunks(i_pre), to_chunks(log_f))
    _, h = lax.scan(step, init, xs)
    return jnp.moveaxis(h, 0, 2).reshape(bsz, nh, seq, dh)


def setup_inputs(seed: int = 0) -> dict:
    key = jax.random.key(seed)
    ks = jax.random.split(key, 24)

    def nrm(k, shape, scale):
        return jax.random.normal(k, shape, jnp.float32) * scale

    def gain(k, n):
        return 1.0 + 0.05 * jax.random.normal(k, (DEPTH, n), jnp.float32)

    return {
        "x": nrm(ks[0], (BATCH, SEQ, D_MODEL), 1.0),
        "p": nrm(ks[1], (DEPTH, BATCH, SEQ, PLE_DIM), 1.0),
        "g_mix_pre": gain(ks[2], D_MODEL),
        "w_in": nrm(ks[3], (DEPTH, D_MODEL, IN_COLS), D_MODEL ** -0.5),
        "b_igate": nrm(ks[4], (DEPTH, ML_HEADS), 0.1),
        "b_fgate": 3.0 + nrm(ks[5], (DEPTH, ML_HEADS), 0.5),
        "w_conv": nrm(ks[6], (DEPTH, CONV_WIDTH, 2 * ML_WIDTH), CONV_WIDTH ** -0.5),
        "b_conv": nrm(ks[7], (DEPTH, 2 * ML_WIDTH), 0.02),
        "g_mlstm_head": gain(ks[8], ML_WIDTH),
        "w_branch_sb": nrm(ks[9], (DEPTH, SB_WIDTH, D_MODEL), SB_WIDTH ** -0.5),
        "w_branch_ml": nrm(ks[10], (DEPTH, ML_WIDTH, D_MODEL), ML_WIDTH ** -0.5),
        "w_out": nrm(ks[11], (DEPTH, D_MODEL, D_MODEL), D_MODEL ** -0.5),
        "g_mix_post": gain(ks[12], D_MODEL),
        "g_mlp_pre": gain(ks[13], D_MODEL),
        "w_mlp_up": nrm(ks[14], (DEPTH, D_MODEL, D_FF), D_MODEL ** -0.5),
        "w_mlp_down": nrm(ks[15], (DEPTH, D_FF, D_MODEL), D_FF ** -0.5),
        "g_mlp_post": gain(ks[16], D_MODEL),
        "g_ple_pre": gain(ks[17], D_MODEL),
        "w_ple_gate": nrm(ks[18], (DEPTH, D_MODEL, D_MODEL), D_MODEL ** -0.5),
        "w_ple_proj": nrm(ks[19], (DEPTH, PLE_DIM, D_MODEL), PLE_DIM ** -0.5),
        "g_ple_post": gain(ks[20], D_MODEL),
    }


def reference(x, p, g_mix_pre, w_in, b_igate, b_fgate, w_conv, b_conv, g_mlstm_head,
              w_branch_sb, w_branch_ml, w_out, g_mix_post, g_mlp_pre, w_mlp_up, w_mlp_down,
              g_mlp_post, g_ple_pre, w_ple_gate, w_ple_proj, g_ple_post):
    f32 = jnp.float32
    bsz, seq, _ = x.shape
    for layer in range(DEPTH):
        h = rmsnorm(x, g_mix_pre[layer])
        z = h @ w_in[layer]
        (q_sb, k_sb, v_sb, q_ml, k_ml, v_ml, o_ml, i_ml, f_ml,
         gate_sb, gate_ml) = jnp.split(z, IN_OFFSETS, axis=-1)

        y_sb = stick_breaking_attention(split_heads(q_sb.astype(f32), SB_HEADS),
                                        split_heads(k_sb.astype(f32), SB_HEADS),
                                        split_heads(v_sb.astype(f32), SB_HEADS))
        y_sb = merge_heads(y_sb).astype(x.dtype)

        qk = jax.nn.silu(causal_depthwise_conv(jnp.concatenate([q_ml, k_ml], axis=-1),
                                               w_conv[layer], b_conv[layer]))
        q_c, k_c = jnp.split(qk, 2, axis=-1)
        i_pre = (i_ml + b_igate[layer]).astype(f32).transpose(0, 2, 1)
        log_f = jax.nn.log_sigmoid((f_ml + b_fgate[layer]).astype(f32)).transpose(0, 2, 1)
        h_ml = mlstm_chunkwise(split_heads(q_c.astype(f32), ML_HEADS),
                               split_heads(k_c.astype(f32), ML_HEADS),
                               split_heads(v_ml.astype(f32), ML_HEADS), i_pre, log_f)
        h_ml = h_ml.transpose(0, 2, 1, 3)
        h_ml = h_ml * lax.rsqrt(jnp.mean(h_ml * h_ml, axis=-1, keepdims=True) + RMS_EPS)
        h_ml = h_ml.reshape(bsz, seq, ML_WIDTH) * g_mlstm_head[layer].astype(f32)
        y_ml = (h_ml * jax.nn.sigmoid(o_ml.astype(f32))).astype(x.dtype)

        merged = (jax.nn.sigmoid(gate_sb) * (y_sb @ w_branch_sb[layer])
                  + jax.nn.sigmoid(gate_ml) * (y_ml @ w_branch_ml[layer]))
        x = x + rmsnorm(merged @ w_out[layer], g_mix_post[layer])

        u = jax.nn.relu(rmsnorm(x, g_mlp_pre[layer]) @ w_mlp_up[layer])
        x = x + rmsnorm((u * u) @ w_mlp_down[layer], g_mlp_post[layer])

        gate = jax.nn.sigmoid(rmsnorm(x, g_ple_pre[layer]) @ w_ple_gate[layer])
        x = x + rmsnorm(gate * (p[layer] @ w_ple_proj[layer]), g_ple_post[layer])
    return x
```

```cpp
#include <hip/hip_runtime.h>
#include <cstdint>
#include <cstdio>
#include <cmath>

namespace nv {
constexpr int D_MODEL = 1024, BATCH = 8, SEQ = 4096, PLE_DIM = 256;
constexpr int SB_HEADS = 8, SB_HD = 64, SB_W = 512;
constexpr int ML_HEADS = 4, ML_HD = 128, ML_W = 512, CONVW = 4;
constexpr int D_FF = 4096, IN_COLS = 5640;
constexpr float RMS_EPS = 1e-6f;
constexpr int O_QSB = 0, O_KSB = 512, O_VSB = 1024, O_QML = 1536, O_KML = 2048, O_VML = 2560, O_OML = 3072, O_I = 3584, O_F = 3588, O_GSB = 3592, O_GML = 4616;
constexpr int NZ1 = 3592;

__global__ void __launch_bounds__(256) gemm_nn(const float* __restrict__ A, int lda, const float* __restrict__ B, int ldb, float* __restrict__ C, int ldc, int M, int N, int K) {
    __shared__ float As[8][128 + 4];
    __shared__ float Bs[8][128 + 4];
    const int tid = threadIdx.x, tx = tid & 15, ty = tid >> 4;
    const int m0 = blockIdx.y * 128, n0 = blockIdx.x * 128;
    float acc[8][8];
#pragma unroll
    for (int i = 0; i < 8; ++i)
#pragma unroll
        for (int j = 0; j < 8; ++j) acc[i][j] = 0.f;
    for (int k0 = 0; k0 < K; k0 += 8) {
#pragma unroll
        for (int r = 0; r < 4; ++r) { const int i = tid + r * 256, m = i >> 3, k = i & 7; As[k][m] = (m0 + m < M) ? A[(size_t)(m0 + m) * lda + k0 + k] : 0.f; }
#pragma unroll
        for (int r = 0; r < 4; ++r) { const int i = tid + r * 256, k = i >> 7, n = i & 127; Bs[k][n] = (n0 + n < N) ? B[(size_t)(k0 + k) * ldb + n0 + n] : 0.f; }
        __syncthreads();
#pragma unroll
        for (int k = 0; k < 8; ++k) {
            float a[8], b[8];
#pragma unroll
            for (int i = 0; i < 8; ++i) a[i] = As[k][ty * 8 + i];
#pragma unroll
            for (int j = 0; j < 8; ++j) b[j] = Bs[k][tx * 8 + j];
#pragma unroll
            for (int i = 0; i < 8; ++i)
#pragma unroll
                for (int j = 0; j < 8; ++j) acc[i][j] = fmaf(a[i], b[j], acc[i][j]);
        }
        __syncthreads();
    }
#pragma unroll
    for (int i = 0; i < 8; ++i) { const int m = m0 + ty * 8 + i; if (m < M) {
#pragma unroll
        for (int j = 0; j < 8; ++j) { const int n = n0 + tx * 8 + j; if (n < N) C[(size_t)m * ldc + n] = acc[i][j]; } } }
}
static void gemm(const float* A, int lda, const float* B, int ldb, float* C, int ldc, int M, int N, int K, hipStream_t s) {
    dim3 g((N + 127) / 128, (M + 127) / 128);
    hipLaunchKernelGGL(gemm_nn, g, dim3(256), 0, s, A, lda, B, ldb, C, ldc, M, N, K);
}

__device__ __forceinline__ float wave_sum(float v) {
#pragma unroll
    for (int o = 1; o < 64; o <<= 1) v += __shfl_xor(v, o);
    return v;
}
__global__ void __launch_bounds__(256) rmsnorm_rows(const float* __restrict__ x, const float* __restrict__ g, const float* res, float* out, int rows) {
    const int row = blockIdx.x * 4 + (threadIdx.x >> 6), lane = threadIdx.x & 63;
    if (row >= rows) return;
    const float* xr = x + (size_t)row * D_MODEL;
    float v[16]; float s = 0.f;
#pragma unroll
    for (int j = 0; j < 16; ++j) { v[j] = xr[lane + 64 * j]; s += v[j] * v[j]; }
    s = wave_sum(s);
    const float rstd = 1.0f / sqrtf(s * (1.0f / D_MODEL) + RMS_EPS);
#pragma unroll
    for (int j = 0; j < 16; ++j) { const int c = lane + 64 * j; const float r = res ? res[(size_t)row * D_MODEL + c] : 0.f; out[(size_t)row * D_MODEL + c] = r + v[j] * rstd * g[c]; }
}

__device__ __forceinline__ float sigmoidf_(float x) { return 1.0f / (1.0f + expf(-x)); }
__device__ __forceinline__ float softplusf_(float x) { return fmaxf(x, 0.f) + log1pf(expf(-fabsf(x))); }

__global__ void __launch_bounds__(64) sb_attn_naive(const float* __restrict__ Z, int ldz, float* __restrict__ Y) {
    const int h = blockIdx.y, t = blockIdx.x * 64 + threadIdx.x, tmax = blockIdx.x * 64 + 63;
    float q[64], y[64];
#pragma unroll
    for (int d = 0; d < 64; ++d) { q[d] = Z[(size_t)t * ldz + O_QSB + h * 64 + d]; y[d] = 0.f; }
    float L = 0.f;
    for (int s = tmax - 1; s >= 0; --s) {
        const float* kr = Z + (size_t)s * ldz + O_KSB + h * 64;
        const float* vr = Z + (size_t)s * ldz + O_VSB + h * 64;
        float z = 0.f;
#pragma unroll
        for (int d = 0; d < 64; ++d) z = fmaf(q[d], kr[d], z);
        z *= 0.125f;
        const bool ok = s < t;
        const float lk = -softplusf_(z);
        const float logb = z + lk;
        const float a = ok ? expf(logb + L) : 0.f;
        if (ok) L += lk;
#pragma unroll
        for (int d = 0; d < 64; ++d) y[d] = fmaf(a, vr[d], y[d]);
    }
#pragma unroll
    for (int d = 0; d < 64; ++d) Y[(size_t)t * SB_W + h * 64 + d] = y[d];
}

__global__ void __launch_bounds__(256) ml_prep(const float* __restrict__ Z, int ldz, const float* __restrict__ wconv, const float* __restrict__ bconv, const float* __restrict__ b_i, const float* __restrict__ b_f,
                                               float* __restrict__ QKC, float* __restrict__ VML, float* __restrict__ OML, float* __restrict__ IG, float* __restrict__ FG) {
    const int t = blockIdx.x;
    for (int c = threadIdx.x; c < 1024; c += 256) {
        float a = bconv[c];
#pragma unroll
        for (int w = 0; w < CONVW; ++w) { const int tt = t - (CONVW - 1) + w; if (tt >= 0) a = fmaf(Z[(size_t)tt * ldz + O_QML + c], wconv[w * 1024 + c], a); }
        QKC[(size_t)t * 1024 + c] = a * sigmoidf_(a);
    }
    for (int c = threadIdx.x; c < 512; c += 256) { VML[(size_t)t * 512 + c] = Z[(size_t)t * ldz + O_VML + c]; OML[(size_t)t * 512 + c] = Z[(size_t)t * ldz + O_OML + c]; }
    if (threadIdx.x < 4) { const int nh = threadIdx.x; IG[(size_t)nh * SEQ + t] = Z[(size_t)t * ldz + O_I + nh] + b_i[nh];
        const float f = Z[(size_t)t * ldz + O_F + nh] + b_f[nh]; FG[(size_t)nh * SEQ + t] = -softplusf_(-f); }
}

__global__ void __launch_bounds__(1024) mlstm_naive(const float* __restrict__ QKC, float* VH, const float* __restrict__ IG, const float* __restrict__ FG) {
    __shared__ float sq[128], sk[128], sv[128];
    const int b = blockIdx.x / ML_HEADS, nh = blockIdx.x % ML_HEADS, tid = threadIdx.x;
    const int v = tid >> 3, ks = (tid & 7) * 16;
    float C[16], n[16];
#pragma unroll
    for (int j = 0; j < 16; ++j) { C[j] = 0.f; n[j] = 0.f; }
    float m = 0.f;
    const float kscale = 0.08838834764831845f;
    for (int t = 0; t < SEQ; ++t) {
        const size_t row = (size_t)b * SEQ + t;
        if (tid < 128) sq[tid] = QKC[row * 1024 + nh * 128 + tid];
        else if (tid < 256) sk[tid - 128] = QKC[row * 1024 + 512 + nh * 128 + (tid - 128)] * kscale;
        else if (tid < 384) sv[tid - 256] = VH[row * 512 + nh * 128 + (tid - 256)];
        const float ig = IG[((size_t)b * ML_HEADS + nh) * SEQ + t], lf = FG[((size_t)b * ML_HEADS + nh) * SEQ + t];
        __syncthreads();
        const float mn = fmaxf(lf + m, ig), a = expf(lf + m - mn), bb = expf(ig - mn);
        m = mn;
        const float vv = sv[v] * bb;
        float pn = 0.f, pd = 0.f;
#pragma unroll
        for (int j = 0; j < 16; ++j) { const float kk = sk[ks + j], qq = sq[ks + j]; C[j] = fmaf(a, C[j], vv * kk); n[j] = fmaf(a, n[j], bb * kk); pn = fmaf(C[j], qq, pn); pd = fmaf(n[j], qq, pd); }
        pn += __shfl_xor(pn, 1); pn += __shfl_xor(pn, 2); pn += __shfl_xor(pn, 4);
        pd += __shfl_xor(pd, 1); pd += __shfl_xor(pd, 2); pd += __shfl_xor(pd, 4);
        const float hval = pn / fmaxf(fabsf(pd), expf(-mn));
        __syncthreads();
        if ((tid & 7) == 0) VH[row * 512 + nh * 128 + v] = hval;
    }
}
__global__ void __launch_bounds__(256) ml_headnorm(float* H, const float* __restrict__ OML, const float* __restrict__ ghead, int n_items) {
    const int item = blockIdx.x * 4 + (threadIdx.x >> 6), lane = threadIdx.x & 63;
    if (item >= n_items) return;
    const int nh = item & 3; const size_t base = (size_t)(item >> 2) * 512 + nh * 128;
    const float a = H[base + lane], b = H[base + lane + 64];
    const float s = wave_sum(a * a + b * b);
    const float rstd = 1.0f / sqrtf(s * (1.0f / 128.0f) + RMS_EPS);
    H[base + lane] = a * rstd * ghead[nh * 128 + lane] * sigmoidf_(OML[base + lane]);
    H[base + lane + 64] = b * rstd * ghead[nh * 128 + lane + 64] * sigmoidf_(OML[base + lane + 64]);
}
__global__ void __launch_bounds__(256) merge_k(const float* __restrict__ G, const float* __restrict__ P1, const float* __restrict__ P2, float* __restrict__ out, int rows) {
    const size_t i = (size_t)blockIdx.x * 256 + threadIdx.x; if (i >= (size_t)rows * 1024) return;
    const size_t r = i >> 10, c = i & 1023;
    out[i] = sigmoidf_(G[r * 2048 + c]) * P1[i] + sigmoidf_(G[r * 2048 + 1024 + c]) * P2[i];
}
__global__ void __launch_bounds__(256) relu2_k(float* u, size_t n) { const size_t i = (size_t)blockIdx.x * 256 + threadIdx.x; if (i < n) { const float r = fmaxf(u[i], 0.f); u[i] = r * r; } }
__global__ void __launch_bounds__(256) sigmul_k(const float* __restrict__ G, float* PP, size_t n) { const size_t i = (size_t)blockIdx.x * 256 + threadIdx.x; if (i < n) PP[i] = sigmoidf_(G[i]) * PP[i]; }

static void launch(void* const* d_in, float* out, unsigned char* ws, hipStream_t s) {
    const float* x = (const float*)d_in[0]; const float* p = (const float*)d_in[1]; const float* g_mix_pre = (const float*)d_in[2]; const float* w_in = (const float*)d_in[3];
    const float* b_ig = (const float*)d_in[4]; const float* b_fg = (const float*)d_in[5]; const float* w_conv = (const float*)d_in[6]; const float* b_conv = (const float*)d_in[7];
    const float* g_head = (const float*)d_in[8]; const float* w_bsb = (const float*)d_in[9]; const float* w_bml = (const float*)d_in[10]; const float* w_out = (const float*)d_in[11];
    const float* g_mix_post = (const float*)d_in[12]; const float* g_mlp_pre = (const float*)d_in[13]; const float* w_up = (const float*)d_in[14]; const float* w_down = (const float*)d_in[15];
    const float* g_mlp_post = (const float*)d_in[16]; const float* g_ple_pre = (const float*)d_in[17]; const float* w_gate = (const float*)d_in[18]; const float* w_proj = (const float*)d_in[19];
    const float* g_ple_post = (const float*)d_in[20];
    const size_t MB = 1u << 20;
    float* H0 = (float*)(ws + 0 * MB);
    float* ZB = (float*)(ws + 16 * MB);
    float* QKC = (float*)(ws + 80 * MB);
    float* VH = (float*)(ws + 208 * MB);
    float* OML = (float*)(ws + 272 * MB);
    float* YSB = (float*)(ws + 336 * MB);
    float* P1 = (float*)(ws + 400 * MB);
    float* P2 = (float*)(ws + 416 * MB);
    float* MG = (float*)(ws + 432 * MB);
    float* Y1 = (float*)(ws + 448 * MB);
    float* IG = (float*)(ws + 464 * MB);
    float* FG = (float*)(ws + 465 * MB);
    float* X = out;
    const int S = SEQ;
    for (int b = 0; b < BATCH; ++b) {
        const float* xb = x + (size_t)b * S * D_MODEL;
        hipLaunchKernelGGL(rmsnorm_rows, dim3(S / 4), dim3(256), 0, s, xb, g_mix_pre, (const float*)nullptr, H0, S);
        gemm(H0, D_MODEL, w_in, IN_COLS, ZB, NZ1, S, NZ1, D_MODEL, s);
        hipLaunchKernelGGL(sb_attn_naive, dim3(S / 64, SB_HEADS), dim3(64), 0, s, ZB, NZ1, YSB + (size_t)b * S * SB_W);
        hipLaunchKernelGGL(ml_prep, dim3(S), dim3(256), 0, s, ZB, NZ1, w_conv, b_conv, b_ig, b_fg, QKC + (size_t)b * S * 1024, VH + (size_t)b * S * 512, OML + (size_t)b * S * 512,
                           IG + (size_t)b * ML_HEADS * S, FG + (size_t)b * ML_HEADS * S);
    }
    hipLaunchKernelGGL(mlstm_naive, dim3(BATCH * ML_HEADS), dim3(1024), 0, s, QKC, VH, IG, FG);
    hipLaunchKernelGGL(ml_headnorm, dim3(BATCH * S), dim3(256), 0, s, VH, OML, g_head, BATCH * S * 4);
    for (int b = 0; b < BATCH; ++b) {
        const float* xb = x + (size_t)b * S * D_MODEL;
        hipLaunchKernelGGL(rmsnorm_rows, dim3(S / 4), dim3(256), 0, s, xb, g_mix_pre, (const float*)nullptr, H0, S);
        gemm(H0, D_MODEL, w_in + O_GSB, IN_COLS, ZB, 2048, S, 2048, D_MODEL, s);
        gemm(YSB + (size_t)b * S * SB_W, SB_W, w_bsb, D_MODEL, P1, D_MODEL, S, D_MODEL, SB_W, s);
        gemm(VH + (size_t)b * S * ML_W, ML_W, w_bml, D_MODEL, P2, D_MODEL, S, D_MODEL, ML_W, s);
        hipLaunchKernelGGL(merge_k, dim3(S * 1024 / 256), dim3(256), 0, s, ZB, P1, P2, MG, S);
        gemm(MG, D_MODEL, w_out, D_MODEL, Y1, D_MODEL, S, D_MODEL, D_MODEL, s);
        hipLaunchKernelGGL(rmsnorm_rows, dim3(S / 4), dim3(256), 0, s, Y1, g_mix_post, xb, X + (size_t)b * S * D_MODEL, S);
    }
    for (int b = 0; b < BATCH; ++b) {
        float* Xb = X + (size_t)b * S * D_MODEL;
        hipLaunchKernelGGL(rmsnorm_rows, dim3(S / 4), dim3(256), 0, s, Xb, g_mlp_pre, (const float*)nullptr, H0, S);
        gemm(H0, D_MODEL, w_up, D_FF, ZB, D_FF, S, D_FF, D_MODEL, s);
        hipLaunchKernelGGL(relu2_k, dim3((unsigned)((size_t)S * D_FF / 256)), dim3(256), 0, s, ZB, (size_t)S * D_FF);
        gemm(ZB, D_FF, w_down, D_MODEL, Y1, D_MODEL, S, D_MODEL, D_FF, s);
        hipLaunchKernelGGL(rmsnorm_rows, dim3(S / 4), dim3(256), 0, s, Y1, g_mlp_post, Xb, Xb, S);
        hipLaunchKernelGGL(rmsnorm_rows, dim3(S / 4), dim3(256), 0, s, Xb, g_ple_pre, (const float*)nullptr, H0, S);
        gemm(H0, D_MODEL, w_gate, D_MODEL, P1, D_MODEL, S, D_MODEL, D_MODEL, s);
        gemm(p + (size_t)b * S * PLE_DIM, PLE_DIM, w_proj, D_MODEL, P2, D_MODEL, S, D_MODEL, PLE_DIM, s);
        hipLaunchKernelGGL(sigmul_k, dim3((unsigned)((size_t)S * D_MODEL / 256)), dim3(256), 0, s, P1, P2, (size_t)S * D_MODEL);
        hipLaunchKernelGGL(rmsnorm_rows, dim3(S / 4), dim3(256), 0, s, P2, g_ple_post, Xb, Xb, S);
    }
}
}

#ifndef NAIVE_NO_ENTRY
extern "C" void kernel_launch(void* const* d_in, const int* in_sizes, int n_in, void* d_out, int out_size, void* d_ws, size_t ws_size, hipStream_t stream) {
    nv::launch(d_in, (float*)d_out, (unsigned char*)d_ws, stream);
}
#endif
```

```cpp
#include <hip/hip_runtime.h>
#include <cstdio>
#include <cstdint>
#include <cmath>
namespace pg8 {
#define PG8_LAS __attribute__((address_space(3)))
typedef unsigned short bf16_t;
typedef short bf16x8 __attribute__((ext_vector_type(8)));
typedef float f32x4 __attribute__((ext_vector_type(4)));
typedef unsigned u32x4 __attribute__((ext_vector_type(4)));
constexpr int BM = 256, BK = 64, HALF = 128, HTB = HALF * BK * 2  , STAGE_BYTES = 8 * HTB, NXCD = 8, WGM = 8;

__host__ __device__ __forceinline__ int lds_byte(int r, int c) { const int st = (r >> 4) * 2 + (c >> 5), rr = r & 15, cc = c & 31, ob = rr * 64 + cc * 2; return st * 1024 + (ob ^ (((ob >> 9) & 1) << 5)); }
__host__ __device__ __forceinline__ void stage_rc(int b, int& R, int& C) { const int st = b / 1024, sb = b % 1024, swz = sb ^ (((sb >> 9) & 1) << 5); R = (st >> 1) * 16 + swz / 64; C = (st & 1) * 32 + (swz % 64) / 2; }
__host__ __device__ __forceinline__ int perm32(int rho) { const int n = rho >> 4, i = rho & 15; return 8 * (i >> 2) + 4 * n + (i & 3); }

struct Unit { int pm, pn; };
struct Gemm { const bf16_t* A; const bf16_t* Bt; int M, N, K; };

struct StaticOrder {
    int nM, nN, nwg, G, c;
    __host__ __device__ void init(int M, int N, int G_, int c_) { nM = M / BM; nN = N / BM; nwg = nM * nN; G = G_; c = c_; }
    __host__ __device__ bool next(int i, Unit& u) const {
        const long L = (long)i * G + c; if (L >= nwg) return false;
        int wgid = (int)L; { const int q = nwg / NXCD, r = nwg % NXCD, xcd = wgid % NXCD, off = wgid / NXCD; wgid = (xcd < r ? xcd * (q + 1) : r * (q + 1) + (xcd - r) * q) + off; }
        const int nig = WGM * nN, gid = wgid / nig, fm = gid * WGM, gsz = (nM - fm) < WGM ? (nM - fm) : WGM;
        u.pm = fm + ((wgid % nig) % gsz); u.pn = (wgid % nig) / gsz; return true;
    }
    __device__ __forceinline__ void a_ready(const Unit&) const {}
    __device__ __forceinline__ void done(const Unit&) const {}
};
__device__ __forceinline__ unsigned cvt_pk_bf16(float lo, float hi) { unsigned r; asm volatile("v_cvt_pk_bf16_f32 %0, %1, %2" : "=v"(r) : "v"(lo), "v"(hi)); return r; }
__device__ __forceinline__ float sigmoid_fast(float x) { return __builtin_amdgcn_rcpf(1.0f + __builtin_amdgcn_exp2f(-1.4426950408889634f * x)); }
__device__ __forceinline__ u32x4 pack8(f32x4 v0, f32x4 v1) { u32x4 w; w.x = cvt_pk_bf16(v0[0], v0[1]); w.y = cvt_pk_bf16(v0[2], v0[3]); w.z = cvt_pk_bf16(v1[0], v1[1]); w.w = cvt_pk_bf16(v1[2], v1[3]); return w; }
__device__ __forceinline__ float bf_lo(unsigned w) { return __uint_as_float(w << 16); }
__device__ __forceinline__ float bf_hi(unsigned w) { return __uint_as_float(w & 0xffff0000u); }
__device__ __forceinline__ void unpack8(u32x4 w, f32x4& v0, f32x4& v1) { v0 = (f32x4){bf_lo(w.x), bf_hi(w.x), bf_lo(w.y), bf_hi(w.y)}; v1 = (f32x4){bf_lo(w.z), bf_hi(w.z), bf_lo(w.w), bf_hi(w.w)}; }

constexpr float SBQ_SCALE = 0.125f * 1.4426950408889634f;
struct EpiIn {
    static constexpr bool PERM = true, AFTER_DRAIN = false;
    bf16_t *qsb, *ksb, *vsb, *qkml, *vml, *oml, *gsb, *gml;
    __device__ __forceinline__ void operator()(const f32x4 (&acc)[2][2][4][2], const Unit& u, int wr, int wc, int fr, int fq) const {
        const int pn = u.pn; bf16_t* base; int ld, colt, mode = 0;
        if (pn < 2) { base = qsb; ld = 512; colt = pn * 256; mode = 1; }
        else if (pn < 4) { base = ksb; ld = 512; colt = (pn - 2) * 256; }
        else if (pn < 6) { base = vsb; ld = 512; colt = (pn - 4) * 256; }
        else if (pn < 10) { base = qkml; ld = 1024; colt = (pn - 6) * 256; }
        else if (pn < 12) { base = vml; ld = 512; colt = (pn - 10) * 256; }
        else if (pn < 14) { base = oml; ld = 512; colt = (pn - 12) * 256; mode = 2; }
        else if (pn < 18) { base = gsb; ld = 1024; colt = (pn - 14) * 256; mode = 2; }
        else { base = gml; ld = 1024; colt = (pn - 18) * 256; mode = 2; }
        const int row0 = u.pm * BM + wr * 64 + fr, col0 = colt + wc * 32 + 8 * fq;
#pragma unroll
        for (int ai = 0; ai < 2; ++ai)
#pragma unroll
            for (int m = 0; m < 4; ++m) { bf16_t* rowp = base + (size_t)(row0 + ai * HALF + m * 16) * ld + col0;
#pragma unroll
                for (int bj = 0; bj < 2; ++bj) { f32x4 v0 = acc[ai][bj][m][0], v1 = acc[ai][bj][m][1];
                    if (mode == 1) { v0 = v0 * SBQ_SCALE; v1 = v1 * SBQ_SCALE; }
                    if (mode == 2) {
#pragma unroll
                        for (int e = 0; e < 4; ++e) { v0[e] = sigmoid_fast(v0[e]); v1[e] = sigmoid_fast(v1[e]); } }
                    *(u32x4*)(rowp + bj * HALF) = pack8(v0, v1); } }
    }
};
template <bool ADD> struct EpiBranch {
    static constexpr bool PERM = true, AFTER_DRAIN = false;
    bf16_t* O; const bf16_t* G;
    __device__ __forceinline__ void operator()(const f32x4 (&acc)[2][2][4][2], const Unit& u, int wr, int wc, int fr, int fq) const {
        const int row0 = u.pm * BM + wr * 64 + fr, col0 = u.pn * BM + wc * 32 + 8 * fq;
#pragma unroll
        for (int ai = 0; ai < 2; ++ai)
#pragma unroll
            for (int m = 0; m < 4; ++m) { const size_t off = (size_t)(row0 + ai * HALF + m * 16) * 1024 + col0;
#pragma unroll
                for (int bj = 0; bj < 2; ++bj) { f32x4 g0, g1; unpack8(*(const u32x4*)(G + off + bj * HALF), g0, g1);
                    f32x4 v0 = acc[ai][bj][m][0] * g0, v1 = acc[ai][bj][m][1] * g1;
                    if (ADD) { f32x4 p0, p1; unpack8(*(const u32x4*)(O + off + bj * HALF), p0, p1); v0 = v0 + p0; v1 = v1 + p1; }
                    *(u32x4*)(O + off + bj * HALF) = pack8(v0, v1); }
                asm volatile("" ::: "memory"); }
    }
};
struct EpiYssq {
    static constexpr bool PERM = true, AFTER_DRAIN = false;
    bf16_t* O; float* ssq;
    __device__ __forceinline__ void operator()(const f32x4 (&acc)[2][2][4][2], const Unit& u, int wr, int wc, int fr, int fq) const {
        const int row0 = u.pm * BM + wr * 64 + fr, col0 = u.pn * BM + wc * 32 + 8 * fq;
#pragma unroll
        for (int ai = 0; ai < 2; ++ai)
#pragma unroll
            for (int m = 0; m < 4; ++m) { const int row = row0 + ai * HALF + m * 16; const size_t off = (size_t)row * 1024 + col0; float s = 0.f;
#pragma unroll
                for (int bj = 0; bj < 2; ++bj) { const f32x4 v0 = acc[ai][bj][m][0], v1 = acc[ai][bj][m][1];
                    s += (v0[0] * v0[0] + v0[1] * v0[1]) + (v0[2] * v0[2] + v0[3] * v0[3]) + (v1[0] * v1[0] + v1[1] * v1[1]) + (v1[2] * v1[2] + v1[3] * v1[3]);
                    *(u32x4*)(O + off + bj * HALF) = pack8(v0, v1); }
                s += __shfl_xor(s, 16); s += __shfl_xor(s, 32);
                if (fq == 0) ssq[(size_t)row * 16 + u.pn * 4 + wc] = s; }
    }
};
struct EpiUp {
    static constexpr bool PERM = true, AFTER_DRAIN = false;
    bf16_t* O; const float* rs;
    __device__ __forceinline__ void operator()(const f32x4 (&acc)[2][2][4][2], const Unit& u, int wr, int wc, int fr, int fq) const {
        const int row0 = u.pm * BM + wr * 64 + fr, col0 = u.pn * BM + wc * 32 + 8 * fq;
#pragma unroll
        for (int ai = 0; ai < 2; ++ai)
#pragma unroll
            for (int m = 0; m < 4; ++m) { const int row = row0 + ai * HALF + m * 16; const float r = rs[row]; const size_t off = (size_t)row * 4096 + col0;
#pragma unroll
                for (int bj = 0; bj < 2; ++bj) { f32x4 v0 = acc[ai][bj][m][0] * r, v1 = acc[ai][bj][m][1] * r;
#pragma unroll
                    for (int e = 0; e < 4; ++e) { const float a = fmaxf(v0[e], 0.f), b = fmaxf(v1[e], 0.f); v0[e] = a * a; v1[e] = b * b; }
                    *(u32x4*)(O + off + bj * HALF) = pack8(v0, v1); } }
    }
};
struct EpiPlain {
    static constexpr bool PERM = true, AFTER_DRAIN = false;
    bf16_t* O;
    __device__ __forceinline__ void operator()(const f32x4 (&acc)[2][2][4][2], const Unit& u, int wr, int wc, int fr, int fq) const {
        const int row0 = u.pm * BM + wr * 64 + fr, col0 = u.pn * BM + wc * 32 + 8 * fq;
#pragma unroll
        for (int ai = 0; ai < 2; ++ai)
#pragma unroll
            for (int m = 0; m < 4; ++m) { const size_t off = (size_t)(row0 + ai * HALF + m * 16) * 1024 + col0;
#pragma unroll
                for (int bj = 0; bj < 2; ++bj) *(u32x4*)(O + off + bj * HALF) = pack8(acc[ai][bj][m][0], acc[ai][bj][m][1]); }
    }
};
struct EpiPle {
    static constexpr bool PERM = true, AFTER_DRAIN = false;
    bf16_t* O; const bf16_t* PP; const float* rs; float* ssq;
    __device__ __forceinline__ void operator()(const f32x4 (&acc)[2][2][4][2], const Unit& u, int wr, int wc, int fr, int fq) const {
        const int row0 = u.pm * BM + wr * 64 + fr, col0 = u.pn * BM + wc * 32 + 8 * fq;
#pragma unroll
        for (int ai = 0; ai < 2; ++ai)
#pragma unroll
            for (int m = 0; m < 4; ++m) { const int row = row0 + ai * HALF + m * 16; const float r = rs[row]; const size_t off = (size_t)row * 1024 + col0; float s = 0.f;
#pragma unroll
                for (int bj = 0; bj < 2; ++bj) { f32x4 p0, p1; unpack8(*(const u32x4*)(PP + off + bj * HALF), p0, p1);
                    f32x4 v0 = acc[ai][bj][m][0] * r, v1 = acc[ai][bj][m][1] * r;
#pragma unroll
                    for (int e = 0; e < 4; ++e) { v0[e] = sigmoid_fast(v0[e]) * p0[e]; v1[e] = sigmoid_fast(v1[e]) * p1[e]; }
                    s += (v0[0] * v0[0] + v0[1] * v0[1]) + (v0[2] * v0[2] + v0[3] * v0[3]) + (v1[0] * v1[0] + v1[1] * v1[1]) + (v1[2] * v1[2] + v1[3] * v1[3]);
                    *(u32x4*)(O + off + bj * HALF) = pack8(v0, v1); }
                s += __shfl_xor(s, 16); s += __shfl_xor(s, 32);
                if (fq == 0) ssq[(size_t)row * 16 + u.pn * 4 + wc] = s;
                asm volatile("" ::: "memory"); }
    }
};
template <class Epi, class Sched, bool ALIGN_EPI = false, bool SP2 = false>
__device__ __forceinline__ void gemm_phase(PG8_LAS unsigned char* lds, const Gemm g, const Sched& S, const Epi& E) {
    const int tid = threadIdx.x, wid = __builtin_amdgcn_readfirstlane(tid >> 6), lane = tid & 63, wr = wid >> 2, wc = wid & 3, fr = lane & 15, fq = lane >> 4;
    const int K = g.K, nt = K / BK;
    unsigned voffA[2], voffB[2];
#pragma unroll
    for (int i = 0; i < 2; ++i) { int R, C; stage_rc(tid * 16 + i * 8192, R, C); const int Rb = Epi::PERM ? ((R & ~31) + perm32(R & 31)) : R;
        voffA[i] = (unsigned)(R * K + C) * 2u; voffB[i] = (unsigned)(Rb * K + C) * 2u; }
    const size_t kstep = (size_t)(BK * 2);
    const size_t hstep = (size_t)HALF * K * 2;
    const size_t tstep = 2 * hstep;
    const unsigned ldsw = (unsigned)wid * 1024u;
    const int aoff = lds_byte(wr * 64 + fr, fq * 8), boff = lds_byte(wc * 32 + fr, fq * 8);
#define PG8_SA(b, h) (((b) * 2 + (h)) * HTB)
#define PG8_SB(b, h) ((4 + (b) * 2 + (h)) * HTB)
#define PG8_STAGE(bufoff, gbase, voff) do { _Pragma("unroll") for (int _i = 0; _i < 2; ++_i) \
        __builtin_amdgcn_global_load_lds((const unsigned*)((const char*)(gbase) + (voff)[_i]), (PG8_LAS unsigned*)(lds + (bufoff) + ldsw + _i * 8192), 16, 0, 0); } while (0)
#define PG8_LDA(dst, b, h) do { _Pragma("unroll") for (int m = 0; m < 4; ++m) _Pragma("unroll") for (int k = 0; k < 2; ++k) dst[m][k] = *(const PG8_LAS bf16x8*)(lds + PG8_SA(b, h) + aoff + m * 2048 + k * 1024); } while (0)
#define PG8_LDB(dst, b, h) do { _Pragma("unroll") for (int n = 0; n < 2; ++n) _Pragma("unroll") for (int k = 0; k < 2; ++k) dst[n][k] = *(const PG8_LAS bf16x8*)(lds + PG8_SB(b, h) + boff + n * 2048 + k * 1024); } while (0)
#define PG8_MMA(ai, bj, At, Bt) do { __builtin_amdgcn_s_setprio(1); _Pragma("unroll") for (int m = 0; m < 4; ++m) _Pragma("unroll") for (int n = 0; n < 2; ++n) _Pragma("unroll") for (int k = 0; k < 2; ++k) \
        acc[ai][bj][m][n] = __builtin_amdgcn_mfma_f32_16x16x32_bf16(Bt[n][k], At[m][k], acc[ai][bj][m][n], 0, 0, 0); __builtin_amdgcn_s_setprio(0); } while (0)
#define PG8_WAIT_V(n) asm volatile("s_waitcnt vmcnt(" #n ")" ::: "memory")
#define PG8_WAIT_L(n) asm volatile("s_waitcnt lgkmcnt(" #n ")" ::: "memory")
#define PG8_BAR __builtin_amdgcn_s_barrier()
#define PG8_SCHED __builtin_amdgcn_sched_barrier(0)
    Unit cur, nxt; int ui = 0;
    if (!S.next(0, cur)) return;
    f32x4 acc[2][2][4][2];
#pragma unroll
    for (int a = 0; a < 2; ++a)
#pragma unroll
        for (int b = 0; b < 2; ++b)
#pragma unroll
            for (int m = 0; m < 4; ++m)
#pragma unroll
                for (int n = 0; n < 2; ++n) acc[a][b][m][n] = (f32x4){0.f, 0.f, 0.f, 0.f};
    bf16x8 At[4][2], B0[2][2], B1[2][2];
    const char* cA = (const char*)g.A + (size_t)cur.pm * tstep; const char* cB = (const char*)g.Bt + (size_t)cur.pn * tstep;
    S.a_ready(cur);
    if constexpr (SP2) {
        PG8_STAGE(PG8_SB(0, 0), cB, voffB); PG8_STAGE(PG8_SB(0, 1), cB + hstep, voffB); PG8_STAGE(PG8_SA(0, 0), cA, voffA); PG8_STAGE(PG8_SA(0, 1), cA + hstep, voffA);
        if (wr == 1) PG8_BAR;
        PG8_WAIT_V(2); PG8_BAR;
        PG8_STAGE(PG8_SB(1, 0), cB + kstep, voffB); PG8_STAGE(PG8_SA(1, 0), cA + kstep, voffA); PG8_STAGE(PG8_SB(1, 1), cB + hstep + kstep, voffB);
        PG8_WAIT_V(6); PG8_BAR;
    } else {
        PG8_STAGE(PG8_SB(0, 0), cB, voffB); PG8_STAGE(PG8_SA(0, 0), cA, voffA); PG8_STAGE(PG8_SB(0, 1), cB + hstep, voffB); PG8_STAGE(PG8_SA(0, 1), cA + hstep, voffA);
        if (wr == 1) PG8_BAR;
        PG8_WAIT_V(4); PG8_BAR;
        PG8_STAGE(PG8_SB(1, 0), cB + kstep, voffB); PG8_STAGE(PG8_SA(1, 0), cA + kstep, voffA); PG8_STAGE(PG8_SB(1, 1), cB + hstep + kstep, voffB);
        PG8_WAIT_V(6); PG8_BAR;
    }
    for (;;) {
        const bool has_next = S.next(ui + 1, nxt);
        const char* nA = has_next ? (const char*)g.A + (size_t)nxt.pm * tstep : cA; const char* nB = has_next ? (const char*)g.Bt + (size_t)nxt.pn * tstep : cB;
        for (int t = 0; t < nt; t += 2) {
            const bool last = (t == nt - 2);
            const char* a1 = cA + (size_t)(t + 1) * kstep;
            const char* a2 = last ? nA : cA + (size_t)(t + 2) * kstep; const char* b2 = last ? nB : cB + (size_t)(t + 2) * kstep;
            const char* a3 = a2 + kstep; const char* b3 = b2 + kstep;
            if (last && has_next) S.a_ready(nxt);
            if constexpr (SP2) {
            PG8_LDB(B0, 0, 0); PG8_LDB(B1, 0, 1); PG8_SCHED; PG8_LDA(At, 0, 0); PG8_STAGE(PG8_SA(1, 1), a1 + hstep, voffA);
            PG8_WAIT_V(8); PG8_WAIT_L(0); PG8_BAR; PG8_MMA(0, 0, At, B0); PG8_MMA(0, 1, At, B1); PG8_BAR; PG8_SCHED;
            PG8_LDA(At, 0, 1); PG8_STAGE(PG8_SB(0, 0), b2, voffB); PG8_STAGE(PG8_SB(0, 1), b2 + hstep, voffB); PG8_STAGE(PG8_SA(0, 0), a2, voffA);
            PG8_WAIT_V(8); PG8_WAIT_L(0); PG8_BAR; PG8_MMA(1, 0, At, B0); PG8_MMA(1, 1, At, B1); PG8_BAR; PG8_SCHED;
            PG8_LDB(B0, 1, 0); PG8_LDB(B1, 1, 1); PG8_SCHED; PG8_LDA(At, 1, 0); PG8_STAGE(PG8_SA(0, 1), a2 + hstep, voffA);
            PG8_WAIT_V(8); PG8_WAIT_L(0); PG8_BAR; PG8_MMA(0, 0, At, B0); PG8_MMA(0, 1, At, B1); PG8_BAR; PG8_SCHED;
            PG8_LDA(At, 1, 1); PG8_STAGE(PG8_SB(1, 0), b3, voffB); PG8_STAGE(PG8_SB(1, 1), b3 + hstep, voffB); PG8_STAGE(PG8_SA(1, 0), a3, voffA);
            PG8_WAIT_V(8); PG8_WAIT_L(0); PG8_BAR; PG8_MMA(1, 0, At, B0); PG8_MMA(1, 1, At, B1); PG8_BAR; PG8_SCHED;
            } else {
            PG8_LDB(B0, 0, 0); PG8_SCHED; PG8_LDA(At, 0, 0); PG8_STAGE(PG8_SA(1, 1), a1 + hstep, voffA);
            PG8_WAIT_L(8); PG8_BAR; PG8_WAIT_L(0); PG8_MMA(0, 0, At, B0); PG8_BAR; PG8_SCHED;
            PG8_LDB(B1, 0, 1); PG8_STAGE(PG8_SB(0, 0), b2, voffB);
            PG8_BAR; PG8_WAIT_L(0); PG8_MMA(0, 1, At, B1); PG8_BAR;
            PG8_LDA(At, 0, 1); PG8_STAGE(PG8_SA(0, 0), a2, voffA);
            PG8_BAR; PG8_WAIT_L(0); PG8_MMA(1, 0, At, B0); PG8_BAR; PG8_SCHED;
            PG8_STAGE(PG8_SB(0, 1), b2 + hstep, voffB);
            PG8_WAIT_V(6); PG8_BAR; PG8_MMA(1, 1, At, B1); PG8_BAR;
            PG8_LDB(B0, 1, 0); PG8_SCHED; PG8_LDA(At, 1, 0); PG8_STAGE(PG8_SA(0, 1), a2 + hstep, voffA);
            PG8_WAIT_L(8); PG8_BAR; PG8_WAIT_L(0); PG8_MMA(0, 0, At, B0); PG8_BAR; PG8_SCHED;
            PG8_LDB(B1, 1, 1); PG8_STAGE(PG8_SB(1, 0), b3, voffB);
            PG8_BAR; PG8_WAIT_L(0); PG8_MMA(0, 1, At, B1); PG8_BAR;
            PG8_LDA(At, 1, 1); PG8_STAGE(PG8_SA(1, 0), a3, voffA);
            PG8_BAR; PG8_WAIT_L(0); PG8_MMA(1, 0, At, B0); PG8_BAR; PG8_SCHED;
            PG8_STAGE(PG8_SB(1, 1), b3 + hstep, voffB);
            PG8_WAIT_V(6); PG8_BAR; PG8_MMA(1, 1, At, B1); PG8_BAR;
            }
        }
        if constexpr (ALIGN_EPI) { if (wr == 0) PG8_BAR; }
        if constexpr (!Epi::AFTER_DRAIN) { E(acc, cur, wr, wc, fr, fq); S.done(cur); }
        if (!has_next) break;
#pragma unroll
        for (int a = 0; a < 2; ++a)
#pragma unroll
            for (int b = 0; b < 2; ++b)
#pragma unroll
                for (int m = 0; m < 4; ++m)
#pragma unroll
                    for (int n = 0; n < 2; ++n) acc[a][b][m][n] = (f32x4){0.f, 0.f, 0.f, 0.f};
        cur = nxt; cA = nA; cB = nB; ++ui;
        if constexpr (ALIGN_EPI) { if (wr == 1) PG8_BAR; }
    }
    PG8_WAIT_V(0);
    if constexpr (!ALIGN_EPI) { if (wr == 0) PG8_BAR; }
    PG8_BAR;
    if constexpr (Epi::AFTER_DRAIN) { E.fused(acc, cur, wr, wc, fr, fq, lds, wid, lane); S.done(cur); }
#undef PG8_SA
#undef PG8_SB
#undef PG8_STAGE
#undef PG8_LDA
#undef PG8_LDB
#undef PG8_MMA
#undef PG8_WAIT_V
#undef PG8_WAIT_L
#undef PG8_BAR
#undef PG8_SCHED
}
}
constexpr int NWAVES = 8;
constexpr int BATCH = 8, SEQ = 4096, DM = 1024, FF = 4096, PLE = 256;
constexpr int M = BATCH * SEQ;
constexpr int IN_COLS = 5640, NIN = 5632;
constexpr int COL_IF = 3584;
constexpr int SBH = 8, SBD = 64, MLH = 4, MLD = 128;
constexpr float RMS_EPS = 1e-6f;

constexpr size_t MiB = 1u << 20;
constexpr size_t WS_CTL = 0, CTL_ZERO_BYTES = 1 * MiB;
constexpr size_t WS_GATES = 1 * MiB;
constexpr size_t WS_SSQ = 2 * MiB;
constexpr size_t WS_RS = 4 * MiB;
constexpr size_t WS_WIN = 6 * MiB, WS_WBSB = 17 * MiB, WS_WBML = 18 * MiB, WS_WOUT = 19 * MiB, WS_WUP = 21 * MiB, WS_WDN = 29 * MiB, WS_WGATE = 37 * MiB, WS_WPROJ = 39 * MiB;
constexpr size_t WS_XN = 40 * MiB;
constexpr size_t WS_PB = 104 * MiB;
constexpr size_t WS_BIG = 120 * MiB;
constexpr size_t WS_QSB = WS_BIG, WS_KSB = WS_BIG + 32 * MiB, WS_VSB = WS_BIG + 64 * MiB, WS_QKML = WS_BIG + 96 * MiB, WS_VML = WS_BIG + 160 * MiB, WS_OML = WS_BIG + 192 * MiB,
                 WS_YSB = WS_BIG + 224 * MiB, WS_YML = WS_BIG + 256 * MiB;
constexpr size_t WS_MERGED = WS_BIG;
constexpr size_t WS_Y1 = WS_BIG + 96 * MiB;
constexpr size_t WS_H = WS_BIG;
constexpr size_t WS_PP = WS_BIG, WS_T = WS_BIG + 64 * MiB;
constexpr size_t WS_END = 408 * MiB;
constexpr size_t WS_DBG = 500 * MiB;
constexpr size_t OUT_GSB = 0, OUT_GML = 64 * MiB, OUT_Y2 = 0;
constexpr int CW_BAR = 4096;
constexpr int CW_QUEUE = 1024;

constexpr int RING_OFF = 0, RING_BYTES = 131072;
constexpr int LDS_BYTES = 163840;
constexpr int MISC_OFF = LDS_BYTES - 256;
#define GAS __attribute__((address_space(1)))
#define LAS __attribute__((address_space(3)))
typedef unsigned short bf16;
typedef unsigned v4u __attribute__((ext_vector_type(4)));
typedef float f32x4 __attribute__((ext_vector_type(4)));
typedef short bf16x8 __attribute__((ext_vector_type(8)));
typedef GAS unsigned gu32;
typedef GAS unsigned long long gu64;
#define RLX_AGENT __ATOMIC_RELAXED, __HIP_MEMORY_SCOPE_AGENT
#define LDS_WAIT() asm volatile("s_waitcnt lgkmcnt(0)" ::: "memory")
#define VM_WAIT() asm volatile("s_waitcnt vmcnt(0)" ::: "memory")
__device__ __forceinline__ unsigned long long rt() { return __builtin_amdgcn_s_memrealtime(); }
__device__ __forceinline__ unsigned f2bf(float f) { unsigned u = __builtin_bit_cast(unsigned, f); return (u + 0x7fffu + ((u >> 16) & 1u)) >> 16; }
__device__ __forceinline__ unsigned pk2(float lo, float hi) { return f2bf(lo) | (f2bf(hi) << 16); }

#define XB_TMO      128
#define XB_XCNT(j)  (256  + 64 * (j))
#define XB_XSUB(j)  (1280 + 64 * (j))
#define XB_XGEN(j)  (2304 + 64 * (j))
#define XB_TOP      3328
#define XB_TOPGEN   3392
#define XCD_BAR_WORDS 3456
#define XB_SPIN_CAP (1u << 18)

__device__ __forceinline__ unsigned xb_ld(unsigned* p)              { return __hip_atomic_load(p, __ATOMIC_RELAXED, __HIP_MEMORY_SCOPE_AGENT); }
__device__ __forceinline__ unsigned xb_add(unsigned* p, unsigned v) { return __hip_atomic_fetch_add(p, v, __ATOMIC_RELAXED, __HIP_MEMORY_SCOPE_AGENT); }
__device__ __forceinline__ unsigned xb_xcc_id() { return (unsigned)__builtin_amdgcn_s_getreg((3 << 11) | 20) & 0xFu; }
#define XB_SPIN(cond, bar) do { unsigned _sp = 0; while (cond) { __builtin_amdgcn_s_sleep(1); \
    if ((++_sp & 255u) == 0u) { if (xb_ld(&(bar)[XB_TMO])) break; if (_sp > XB_SPIN_CAP) { atomicAdd(&(bar)[XB_TMO], 1u); break; } } } } while (0)

struct XcdBarrier {
    unsigned* bar; unsigned x;
    volatile LAS unsigned* st;
};

__device__ __forceinline__ XcdBarrier xcd_barrier_post(unsigned* bar, volatile LAS unsigned* st) {
    XcdBarrier b; b.bar = bar; b.x = xb_xcc_id(); b.st = st;
    if (threadIdx.x == 0) (void)xb_add(&bar[XB_XCNT(b.x)], 1u);
    return b;
}
__device__ __forceinline__ void xcd_barrier_complete(unsigned* bar, unsigned x, unsigned& nloc, unsigned& nx) {
    const unsigned G = gridDim.x * gridDim.y * gridDim.z;
    unsigned sum, cnt, mine, sp = 0u;
    for (;;) {
        sum = 0u; cnt = 0u; mine = 0u;
#pragma unroll
        for (unsigned j = 0; j < 16; ++j) { const unsigned c = xb_ld(&bar[XB_XCNT(j)]); sum += c; cnt += (c > 0u) ? 1u : 0u; mine = (j == x) ? c : mine; }
        if (sum == G) break;
        __builtin_amdgcn_s_sleep(1);
        if ((++sp & 255u) == 0u) { if (xb_ld(&bar[XB_TMO])) break; if (sp > XB_SPIN_CAP) { atomicAdd(&bar[XB_TMO], 1u); break; } }
    }
    nloc = mine > 0u ? mine : 1u; nx = cnt > 0u ? cnt : 1u;
}

__device__ __forceinline__ void xcd_barrier(const XcdBarrier& b) {
    asm volatile("s_waitcnt vmcnt(0)" ::: "memory");
    __syncthreads();
    if (threadIdx.x == 0) {
        unsigned* bar = b.bar;
        __builtin_amdgcn_s_waitcnt(0);
        unsigned nloc = b.st[0], nx = b.st[1];
        if (nloc == 0u) { xcd_barrier_complete(bar, b.x, nloc, nx); b.st[0] = nloc; b.st[1] = nx; }
        const unsigned old = xb_add(&bar[XB_XSUB(b.x)], 1u);
        const unsigned gen = old / nloc;
        if (old + 1u == (gen + 1u) * nloc) {
            __builtin_amdgcn_fence(__ATOMIC_RELEASE, "agent");
            asm volatile("s_waitcnt vmcnt(0)" ::: "memory");
            const unsigned og = xb_add(&bar[XB_TOP], 1u);
            const unsigned tg = og / nx;
            if (og + 1u == (tg + 1u) * nx) xb_add(&bar[XB_TOPGEN], 1u);
            else XB_SPIN(xb_ld(&bar[XB_TOPGEN]) == tg, bar);
            __builtin_amdgcn_fence(__ATOMIC_ACQUIRE, "agent");
            xb_add(&bar[XB_XGEN(b.x)], 1u);
            asm volatile("s_waitcnt vmcnt(0)" ::: "memory");
        } else {
            XB_SPIN(xb_ld(&bar[XB_XGEN(b.x)]) == gen, bar);
            __builtin_amdgcn_fence(__ATOMIC_ACQUIRE, "agent");
            asm volatile("s_waitcnt vmcnt(0)" ::: "memory");
        }
    }
    __syncthreads();
}
struct Frame {
    LAS unsigned char* lds;
    volatile LAS unsigned* MISC;
    gu32* ctl;
    int tid, lane, wave;
    int vcu, G;
};

__device__ __forceinline__ float wave_sum(float v) {
#pragma unroll
    for (int o = 1; o < 64; o <<= 1) v += __shfl_xor(v, o);
    return v;
}
__device__ __forceinline__ float softplus_f(float x) { return fmaxf(x, 0.f) + log1pf(expf(-fabsf(x))); }
__device__ __forceinline__ void p0_transpose_item(const float* W, int ldw, int coloff, int K, int N, bf16* WT, const float* gk, LAS float* scr, int item, int lane) {
    const int nblk = N / 32, kb = item / nblk, nb = item % nblk, k0 = 64 * kb, n0 = 32 * nb;
#pragma unroll 8
    for (int i = 0; i < 32; ++i) { const int kk = 2 * i + (lane >> 5); float v = W[(size_t)(k0 + kk) * ldw + coloff + n0 + (lane & 31)]; if (gk) v *= gk[k0 + kk]; scr[kk * 33 + (lane & 31)] = v; }
    LDS_WAIT(); asm volatile("" ::: "memory");
    const int c = lane & 7;
#pragma unroll
    for (int j = 0; j < 4; ++j) { const int n = (lane >> 3) + 8 * j; const LAS float* s = scr + (8 * c) * 33 + n;
        v4u o; o.x = pk2(s[0 * 33], s[1 * 33]); o.y = pk2(s[2 * 33], s[3 * 33]); o.z = pk2(s[4 * 33], s[5 * 33]); o.w = pk2(s[6 * 33], s[7 * 33]);
        *(GAS v4u*)(WT + (size_t)(n0 + n) * K + k0 + 8 * c) = o; }
    LDS_WAIT(); asm volatile("" ::: "memory");
}

struct Ptrs {
    const float *x, *p, *g_mix_pre, *w_in, *b_ig, *b_fg, *w_conv, *b_conv, *g_head, *w_bsb, *w_bml, *w_out, *g_mix_post, *g_mlp_pre, *w_up, *w_dn, *g_mlp_post, *g_ple_pre, *w_gate, *w_proj, *g_ple_post;
    float* out; unsigned char* ws;
};

__device__ __forceinline__ void p0_prologue(Frame& F, const Ptrs& P) {
    LAS float* scr = (LAS float*)(F.lds + RING_OFF + F.wave * 16384);
    const int gw = F.vcu * NWAVES + F.wave, NGW = F.G * NWAVES;
    unsigned char* ws = P.ws;
    constexpr int I_IN = (DM / 64) * (NIN / 32), I_BS = (512 / 64) * (DM / 32), I_OUT = (DM / 64) * (DM / 32), I_UP = (DM / 64) * (FF / 32), I_DN = (FF / 64) * (DM / 32), I_PJ = (PLE / 64) * (DM / 32);
    constexpr int NITEMS = I_IN + 2 * I_BS + I_OUT + I_UP + I_DN + I_OUT + I_PJ;
    for (int it = gw; it < NITEMS; it += NGW) {
        int r = it;
        if (r < I_IN) { const int n0 = 32 * (r % (NIN / 32)); p0_transpose_item(P.w_in, IN_COLS, n0 >= COL_IF ? 8 : 0, DM, NIN, (bf16*)(ws + WS_WIN), nullptr, scr, r, F.lane); continue; } r -= I_IN;
        if (r < I_BS) { p0_transpose_item(P.w_bsb, DM, 0, 512, DM, (bf16*)(ws + WS_WBSB), nullptr, scr, r, F.lane); continue; } r -= I_BS;
        if (r < I_BS) { p0_transpose_item(P.w_bml, DM, 0, 512, DM, (bf16*)(ws + WS_WBML), nullptr, scr, r, F.lane); continue; } r -= I_BS;
        if (r < I_OUT) { p0_transpose_item(P.w_out, DM, 0, DM, DM, (bf16*)(ws + WS_WOUT), nullptr, scr, r, F.lane); continue; } r -= I_OUT;
        if (r < I_UP) { p0_transpose_item(P.w_up, FF, 0, DM, FF, (bf16*)(ws + WS_WUP), P.g_mlp_pre, scr, r, F.lane); continue; } r -= I_UP;
        if (r < I_DN) { p0_transpose_item(P.w_dn, DM, 0, FF, DM, (bf16*)(ws + WS_WDN), nullptr, scr, r, F.lane); continue; } r -= I_DN;
        if (r < I_OUT) { p0_transpose_item(P.w_gate, DM, 0, DM, DM, (bf16*)(ws + WS_WGATE), P.g_ple_pre, scr, r, F.lane); continue; } r -= I_OUT;
        p0_transpose_item(P.w_proj, DM, 0, PLE, DM, (bf16*)(ws + WS_WPROJ), nullptr, scr, r, F.lane);
    }
    { const GAS f32x4* src = (const GAS f32x4*)P.p; GAS unsigned long long* dst = (GAS unsigned long long*)(ws + WS_PB);
      const size_t n4 = (size_t)M * PLE / 4;
      for (size_t i = (size_t)gw * 64 + F.lane; i < n4; i += (size_t)NGW * 64) { const f32x4 v = src[i]; dst[i] = (unsigned long long)pk2(v.x, v.y) | ((unsigned long long)pk2(v.z, v.w) << 32); } }
    __syncthreads();
    LAS float* Wg = (LAS float*)(F.lds + RING_OFF);
    for (int e = F.tid; e < 8 * DM; e += NWAVES * 64) { const int k = e >> 3, j = e & 7; Wg[j * DM + k] = P.w_in[(size_t)k * IN_COLS + COL_IF + j]; }
    __syncthreads();
    f32x4 gm[4];
#pragma unroll
    for (int j = 0; j < 4; ++j) gm[j] = ((const GAS f32x4*)P.g_mix_pre)[F.lane + 64 * j];
    const float bias = F.lane < 4 ? P.b_ig[F.lane] : (F.lane < 8 ? P.b_fg[F.lane - 4] : 0.f);
    float* gates = (float*)(ws + WS_GATES);
    for (int m = gw; m < M; m += NGW) {
        const GAS f32x4* xr = (const GAS f32x4*)(P.x + (size_t)m * DM) + F.lane;
        f32x4 v[4]; float s = 0.f;
#pragma unroll
        for (int j = 0; j < 4; ++j) { v[j] = xr[64 * j]; s += (v[j].x * v[j].x + v[j].y * v[j].y) + (v[j].z * v[j].z + v[j].w * v[j].w); }
        const float rstd = 1.f / sqrtf(wave_sum(s) * (1.f / DM) + RMS_EPS);
#pragma unroll
        for (int j = 0; j < 4; ++j) v[j] = v[j] * rstd * gm[j];
        GAS unsigned long long* o8 = (GAS unsigned long long*)(ws + WS_XN + (size_t)m * DM * 2) + F.lane;
#pragma unroll
        for (int j = 0; j < 4; ++j) o8[64 * j] = (unsigned long long)pk2(v[j].x, v[j].y) | ((unsigned long long)pk2(v[j].z, v[j].w) << 32);
        float mine = 0.f;
#pragma unroll
        for (int g = 0; g < 8; ++g) { float a = 0.f;
#pragma unroll
            for (int j = 0; j < 4; ++j) { const f32x4 w = *(const LAS f32x4*)(Wg + g * DM + 4 * F.lane + 256 * j); a += (v[j].x * w.x + v[j].y * w.y) + (v[j].z * w.z + v[j].w * w.w); }
            a = wave_sum(a); if (F.lane == g) mine = a; }
        if (F.lane < 8) { float val = mine + bias; if (F.lane >= 4) val = -softplus_f(-val); gates[(size_t)m * 8 + F.lane] = val; }
    }
    __syncthreads();
}

template <bool XIN_F32> __device__ __forceinline__ void ew_residual(Frame& F, const float* x, const bf16* Y, const float* ssq, const float* g, bf16* XN, float* RS) {
    const int gw = F.vcu * NWAVES + F.wave, NGW = F.G * NWAVES;
    f32x4 gm[4];
#pragma unroll
    for (int j = 0; j < 4; ++j) gm[j] = ((const GAS f32x4*)g)[F.lane + 64 * j];
    for (int m = gw; m < M; m += NGW) {
        float sq = F.lane < 16 ? ssq[(size_t)m * 16 + F.lane] : 0.f;
        sq = wave_sum(sq);
        const float rstd_y = 1.f / sqrtf(sq * (1.f / DM) + RMS_EPS);
        f32x4 v[4]; float s = 0.f;
        const GAS unsigned long long* y8 = (const GAS unsigned long long*)(Y + (size_t)m * DM) + F.lane;
        GAS unsigned long long* o8 = (GAS unsigned long long*)(XN + (size_t)m * DM) + F.lane;
#pragma unroll
        for (int j = 0; j < 4; ++j) {
            f32x4 xi;
            if (XIN_F32) xi = ((const GAS f32x4*)(x + (size_t)m * DM))[F.lane + 64 * j];
            else { const unsigned long long w = o8[64 * j]; const unsigned lo = (unsigned)w, hi = (unsigned)(w >> 32); xi = (f32x4){__uint_as_float(lo << 16), __uint_as_float(lo & 0xffff0000u), __uint_as_float(hi << 16), __uint_as_float(hi & 0xffff0000u)}; }
            const unsigned long long w = y8[64 * j]; const unsigned lo = (unsigned)w, hi = (unsigned)(w >> 32);
            const f32x4 yv = (f32x4){__uint_as_float(lo << 16), __uint_as_float(lo & 0xffff0000u), __uint_as_float(hi << 16), __uint_as_float(hi & 0xffff0000u)};
            v[j] = xi + yv * rstd_y * gm[j];
            s += (v[j].x * v[j].x + v[j].y * v[j].y) + (v[j].z * v[j].z + v[j].w * v[j].w);
        }
        s = wave_sum(s);
#pragma unroll
        for (int j = 0; j < 4; ++j) o8[64 * j] = (unsigned long long)pk2(v[j].x, v[j].y) | ((unsigned long long)pk2(v[j].z, v[j].w) << 32);
        if (F.lane == 0) RS[m] = 1.f / sqrtf(s * (1.f / DM) + RMS_EPS);
    }
}
__device__ __forceinline__ void ew_final(Frame& F, const bf16* XN, const bf16* T, const float* ssq, const float* g, float* out) {
    const int gw = F.vcu * NWAVES + F.wave, NGW = F.G * NWAVES;
    f32x4 gm[4];
#pragma unroll
    for (int j = 0; j < 4; ++j) gm[j] = ((const GAS f32x4*)g)[F.lane + 64 * j];
    for (int m = gw; m < M; m += NGW) {
        float sq = F.lane < 16 ? ssq[(size_t)m * 16 + F.lane] : 0.f;
        sq = wave_sum(sq);
        const float rstd_t = 1.f / sqrtf(sq * (1.f / DM) + RMS_EPS);
        const GAS unsigned long long* t8 = (const GAS unsigned long long*)(T + (size_t)m * DM) + F.lane;
        const GAS unsigned long long* x8 = (const GAS unsigned long long*)(XN + (size_t)m * DM) + F.lane;
        GAS f32x4* o = (GAS f32x4*)(out + (size_t)m * DM) + F.lane;
#pragma unroll
        for (int j = 0; j < 4; ++j) {
            const unsigned long long wx = x8[64 * j], wt = t8[64 * j]; const unsigned xl = (unsigned)wx, xh = (unsigned)(wx >> 32), tl = (unsigned)wt, th = (unsigned)(wt >> 32);
            const f32x4 xi = (f32x4){__uint_as_float(xl << 16), __uint_as_float(xl & 0xffff0000u), __uint_as_float(xh << 16), __uint_as_float(xh & 0xffff0000u)};
            const f32x4 tv = (f32x4){__uint_as_float(tl << 16), __uint_as_float(tl & 0xffff0000u), __uint_as_float(th << 16), __uint_as_float(th & 0xffff0000u)};
            o[64 * j] = xi + tv * rstd_t * gm[j];
        }
    }
}
namespace sbat {
using bf16x8 = __attribute__((ext_vector_type(8))) short;
using s16x4 = __attribute__((ext_vector_type(4))) short;
using f32x16 = __attribute__((ext_vector_type(16))) float;
using u32x4 = __attribute__((ext_vector_type(4))) unsigned;
constexpr int PITCH = 512;
constexpr int NSLOT = 2, SLOTB = 8192;
constexpr int LDS_K = 0, LDS_V = NSLOT * SLOTB, LDS_OST = 2 * NSLOT * SLOTB, LDS_BYTES = LDS_OST + NWAVES * 4096;
__device__ __forceinline__ int crow(int r, int hi) { return (r & 3) + 8 * (r >> 2) + 4 * hi; }
#define SBAR() __builtin_amdgcn_sched_barrier(0)
__device__ __forceinline__ void glds16(const void* gsrc, unsigned lds_dst) { unsigned keep;
    asm volatile("s_mov_b32 %0, m0\n\ts_mov_b32 m0, %2\n\ts_nop 0\n\tglobal_load_lds_dwordx4 %1, off\n\ts_mov_b32 m0, %0" : "=&s"(keep) : "v"(gsrc), "s"(lds_dst) : "memory"); }
typedef float f32x2_t __attribute__((ext_vector_type(2))); typedef __bf16 bf16x2_t __attribute__((ext_vector_type(2)));
__device__ __forceinline__ unsigned cvtpk_s(float lo, float hi) { f32x2_t v = {lo, hi}; bf16x2_t b = __builtin_convertvector(v, bf16x2_t); return __builtin_bit_cast(unsigned, b); }
#define WAIT_BAR(N) asm volatile("s_waitcnt vmcnt(" #N ") lgkmcnt(0)\n\ts_barrier" ::: "memory")
typedef __attribute__((address_space(3))) const char* lds_cptr;
__device__ __forceinline__ void pv(f32x16* o, int vb, bf16x8 pa0, bf16x8 pa1, bf16x8 pa2, bf16x8 pa3) {
#pragma unroll
    for (int d0 = 0; d0 < 2; ++d0) { s16x4 lo[4], hi[4];
#pragma unroll
        for (int ks = 0; ks < 4; ++ks) {
            asm volatile("ds_read_b64_tr_b16 %0,%1 offset:%c2" : "=&v"(lo[ks]) : "v"(vb), "i"(d0 * 4096 + ks * 1024) : "memory");
            asm volatile("ds_read_b64_tr_b16 %0,%1 offset:%c2" : "=&v"(hi[ks]) : "v"(vb), "i"(d0 * 4096 + ks * 1024 + 512) : "memory"); }
        asm volatile("s_waitcnt lgkmcnt(0)" ::: "memory"); SBAR();
#define PK(k) (bf16x8){lo[k][0], lo[k][1], lo[k][2], lo[k][3], hi[k][0], hi[k][1], hi[k][2], hi[k][3]}
        o[d0] = __builtin_amdgcn_mfma_f32_32x32x16_bf16(pa0, PK(0), o[d0], 0, 0, 0);
        o[d0] = __builtin_amdgcn_mfma_f32_32x32x16_bf16(pa1, PK(1), o[d0], 0, 0, 0);
        o[d0] = __builtin_amdgcn_mfma_f32_32x32x16_bf16(pa2, PK(2), o[d0], 0, 0, 0);
        o[d0] = __builtin_amdgcn_mfma_f32_32x32x16_bf16(pa3, PK(3), o[d0], 0, 0, 0);
#undef PK
    }
}
template <bool MASKED> __device__ __forceinline__ void sb_tile_math(f32x16& p0, f32x16& p1, float& R, int qrel, int hi, u32x4& pw0, u32x4& pw1, u32x4& pw2, u32x4& pw3) {
    f32x16 k0, k1;
#pragma unroll
    for (int r = 0; r < 16; ++r) {
        float e0 = __builtin_amdgcn_exp2f(fminf(p0[r], 86.0f)), e1 = __builtin_amdgcn_exp2f(fminf(p1[r], 86.0f));
        float c0 = __builtin_amdgcn_rcpf(1.0f + e0), c1 = __builtin_amdgcn_rcpf(1.0f + e1);
        if (MASKED) { const int kk = crow(r, hi); if (kk >= qrel) { e0 = 0.f; c0 = 1.f; } if (kk + 32 >= qrel) { e1 = 0.f; c1 = 1.f; } }
        p0[r] = e0; p1[r] = e1; k0[r] = c0; k1[r] = c1;
    }
    float glo0[4], ghi0[4], glo1[4], ghi1[4];
#pragma unroll
    for (int g = 0; g < 4; ++g) {
        const float a = (k0[4 * g] * k0[4 * g + 1]) * (k0[4 * g + 2] * k0[4 * g + 3]), b = (k1[4 * g] * k1[4 * g + 1]) * (k1[4 * g + 2] * k1[4 * g + 3]);
        auto ra = __builtin_amdgcn_permlane32_swap(__float_as_uint(a), __float_as_uint(a), false, false);
        auto rb = __builtin_amdgcn_permlane32_swap(__float_as_uint(b), __float_as_uint(b), false, false);
        glo0[g] = __uint_as_float(ra[0]); ghi0[g] = __uint_as_float(ra[1]); glo1[g] = __uint_as_float(rb[0]); ghi1[g] = __uint_as_float(rb[1]);
    }
    float c = R;
    float st1[4], st0[4];
#pragma unroll
    for (int g = 3; g >= 0; --g) { const float sh = c; c *= ghi1[g]; const float sl = c; c *= glo1[g]; st1[g] = hi ? sh : sl; }
#pragma unroll
    for (int g = 3; g >= 0; --g) { const float sh = c; c *= ghi0[g]; const float sl = c; c *= glo0[g]; st0[g] = hi ? sh : sl; }
    R = c;
#pragma unroll
    for (int g = 0; g < 4; ++g) {
        float s1 = st1[g], s0 = st0[g];
#pragma unroll
        for (int i = 3; i >= 0; --i) { s1 *= k1[4 * g + i]; p1[4 * g + i] *= s1; s0 *= k0[4 * g + i]; p0[4 * g + i] *= s0; }
    }
    pw0 = (u32x4){cvtpk_s(p0[0], p0[1]), cvtpk_s(p0[2], p0[3]), cvtpk_s(p0[4], p0[5]), cvtpk_s(p0[6], p0[7])};
    pw1 = (u32x4){cvtpk_s(p0[8], p0[9]), cvtpk_s(p0[10], p0[11]), cvtpk_s(p0[12], p0[13]), cvtpk_s(p0[14], p0[15])};
    pw2 = (u32x4){cvtpk_s(p1[0], p1[1]), cvtpk_s(p1[2], p1[3]), cvtpk_s(p1[4], p1[5]), cvtpk_s(p1[6], p1[7])};
    pw3 = (u32x4){cvtpk_s(p1[8], p1[9]), cvtpk_s(p1[10], p1[11]), cvtpk_s(p1[12], p1[13]), cvtpk_s(p1[14], p1[15])};
}

__device__ __forceinline__ void sb_unit(int b, int h, int qb, const bf16* Q, const bf16* K, const bf16* V, bf16* O, LAS unsigned char* lds) {
    const int tid = threadIdx.x, lane = tid & 63, r32 = lane & 31, hi = lane >> 5; const int wid = __builtin_amdgcn_readfirstlane(tid >> 6);
    const long rowbase = (long)b * SEQ; const int q0 = qb * 256, tw = q0 + wid * 32;
    const bf16* Qw = Q + (rowbase + tw) * PITCH + h * SBD;
    const bf16* Kh = K + rowbase * PITCH + h * SBD; const bf16* Vh = V + rowbase * PITCH + h * SBD;
    const unsigned lds0 = (unsigned)(uintptr_t)lds;
    const bf16* ksrc = Kh + (long)lane * PITCH + wid * 8;
    const bf16* vsrc = Vh + (long)(16 * (wid & 3) + (lane >> 2)) * PITCH + (wid >> 2) * 32 + (lane & 3) * 8;
    const unsigned kdst = lds0 + LDS_K + wid * 1024, vdst = lds0 + LDS_V + wid * 1024;
#define DMA_K(t, slot) glds16(ksrc + (long)(t) * 64 * PITCH, (unsigned)__builtin_amdgcn_readfirstlane(kdst + (slot)))
#define DMA_V(t, slot) glds16(vsrc + (long)(t) * 64 * PITCH, (unsigned)__builtin_amdgcn_readfirstlane(vdst + (slot)))
    const int vb0 = (int)(lds0 + LDS_V) + ((lane >> 4) & 1) * 32 + (lane & 3) * 8 + (4 * hi + ((lane & 15) >> 2)) * 64;
    const lds_cptr kp0 = (lds_cptr)lds + LDS_K + hi * 1024 + r32 * 16;
    const int NT = (q0 + 256) / 64;
    DMA_K(NT - 1, 0); DMA_V(NT - 1, 0);
    bf16x8 qr[4];
#pragma unroll
    for (int d0 = 0; d0 < 4; ++d0) qr[d0] = *reinterpret_cast<const bf16x8*>(&Qw[(long)r32 * PITCH + d0 * 16 + hi * 8]);
    f32x16 o[2]; o[0] = f32x16{}; o[1] = f32x16{};
    float R = 1.0f;
    int slot = 0;
    for (int t = NT - 1; t >= 0; --t) {
        if (t > 0) { DMA_K(t - 1, slot ^ SLOTB); DMA_V(t - 1, slot ^ SLOTB); WAIT_BAR(2); } else { WAIT_BAR(0); }
        const int qrel = tw + r32 - 64 * t;
        if (64 * t < tw + 31) {
            f32x16 p0 = f32x16{}, p1 = f32x16{};
            const lds_cptr kb = kp0 + slot;
#pragma unroll
            for (int d0 = 0; d0 < 4; ++d0) {
                const bf16x8 b0 = *(const __attribute__((address_space(3))) bf16x8*)(kb + d0 * 2048);
                const bf16x8 b1 = *(const __attribute__((address_space(3))) bf16x8*)(kb + d0 * 2048 + 512);
                p0 = __builtin_amdgcn_mfma_f32_32x32x16_bf16(b0, qr[d0], p0, 0, 0, 0);
                p1 = __builtin_amdgcn_mfma_f32_32x32x16_bf16(b1, qr[d0], p1, 0, 0, 0);
            }
            u32x4 pw0, pw1, pw2, pw3;
            if (64 * t + 63 >= tw) sb_tile_math<true>(p0, p1, R, qrel, hi, pw0, pw1, pw2, pw3);
            else sb_tile_math<false>(p0, p1, R, qrel, hi, pw0, pw1, pw2, pw3);
            pv(o, vb0 + slot, __builtin_bit_cast(bf16x8, pw0), __builtin_bit_cast(bf16x8, pw1), __builtin_bit_cast(bf16x8, pw2), __builtin_bit_cast(bf16x8, pw3));
        }
        asm volatile("s_waitcnt lgkmcnt(0)\n\ts_barrier" ::: "memory");
        slot ^= SLOTB;
    }
    bf16* Ow = O + (rowbase + tw) * PITCH + h * SBD;
    { LAS bf16* stg = (LAS bf16*)(lds + LDS_OST) + wid * 2048;
#pragma unroll
      for (int r = 0; r < 16; ++r) { const int orow = crow(r, hi);
#pragma unroll
          for (int d0 = 0; d0 < 2; ++d0) stg[orow * 64 + d0 * 32 + r32] = (bf16)(cvtpk_s(o[d0][r], 0.f) & 0xffffu); }
      asm volatile("s_waitcnt lgkmcnt(0)" ::: "memory");
#pragma unroll
      for (int i = 0; i < 4; ++i) { const int row = i * 8 + (lane >> 3), ch = lane & 7; const u32x4 v = *(const LAS u32x4*)(stg + row * 64 + ch * 8); *(u32x4*)(Ow + (long)row * PITCH + ch * 8) = v; } }
    asm volatile("s_waitcnt vmcnt(0) lgkmcnt(0)\n\ts_barrier" ::: "memory");
#undef DMA_K
#undef DMA_V
}
#undef SBAR
#undef WAIT_BAR
}


namespace mlst {
using bf16x8 = __attribute__((ext_vector_type(8))) short;
using f32x4 = __attribute__((ext_vector_type(4))) float;
using u32x4 = __attribute__((ext_vector_type(4))) unsigned;
constexpr int QST = 136, TST = 72, CST = 136;
constexpr int L_QS = 0, L_KS = 17408, L_KTW = 34816, L_VT = 53248, L_CB = 73984, L_SP = 113152, L_SC = 122368;
constexpr int SC_A = 0, SC_CM = 64, SC_INTER = 128, SC_EMT = 192, SC_W = 256, SC_DEN = 320, SC_HSQ = 384;
static_assert(L_SC + (SC_HSQ + 512) * 4 <= RING_BYTES, "mLSTM LDS map");
__device__ __forceinline__ bf16x8 ldfrag(LAS const unsigned char* base, int stride_el, int row0, int k0, int lo) {
    return *(const LAS bf16x8*)(base + lo + (row0 * stride_el + k0) * 2); }
__device__ __forceinline__ float bflo(unsigned w) { return __uint_as_float(w << 16); }
__device__ __forceinline__ float bfhi(unsigned w) { return __uint_as_float(w & 0xffff0000u); }
__device__ __forceinline__ float silu_f(float x) { return x * __builtin_amdgcn_rcpf(1.0f + __builtin_amdgcn_exp2f(-1.4426950408889634f * x)); }
#define MFMA16(a, b, c) __builtin_amdgcn_mfma_f32_16x16x32_bf16((a), (b), (c), 0, 0, 0)

__device__ __forceinline__ void chain(int b, int nh, const Ptrs& P, LAS unsigned char* lds) {
    const int tid = threadIdx.x, lane = tid & 63; const int wid = __builtin_amdgcn_readfirstlane(tid >> 6);
    const unsigned char* ws = P.ws;
    const bf16* QKML = (const bf16*)(ws + WS_QKML); const bf16* VML = (const bf16*)(ws + WS_VML); const bf16* OML = (const bf16*)(ws + WS_OML); bf16* YML = (bf16*)(ws + WS_YML);
    const float* GATES = (const float*)(ws + WS_GATES);
    LAS unsigned char* QS = lds + L_QS; LAS unsigned char* KS = lds + L_KS; LAS unsigned char* KTW = lds + L_KTW; LAS unsigned char* VT = lds + L_VT; LAS unsigned char* CB = lds + L_CB; LAS unsigned char* SP = lds + L_SP;
    LAS float* SC = (LAS float*)(lds + L_SC);
    const size_t rowbase = (size_t)b * SEQ;
    const int dp = tid & 63, rg = wid;
    const int fr = lane & 15, fq = lane >> 4;
    for (int e = tid; e < 144 * CST / 2; e += NWAVES * 64) ((LAS unsigned*)CB)[e] = 0u;
    for (int e = tid; e < 16 * TST / 2; e += NWAVES * 64) ((LAS unsigned*)(VT + 128 * TST * 2))[e] = (e < TST / 2) ? 0x3F803F80u : 0u;
    float wq[4][2], wk[4][2], bq[2], bk[2];
#pragma unroll
    for (int j = 0; j < 2; ++j) { const int cq = nh * 128 + 2 * dp + j, ck = 512 + cq; bq[j] = P.b_conv[cq]; bk[j] = P.b_conv[ck];
#pragma unroll
        for (int w = 0; w < 4; ++w) { wq[w][j] = P.w_conv[w * 1024 + cq]; wk[w][j] = P.w_conv[w * 1024 + ck]; } }
    const float gh = P.g_head[nh * 128 + 16 * wid + fr];
    f32x4 Cacc[9];
#pragma unroll
    for (int i = 0; i < 9; ++i) Cacc[i] = (f32x4){0.f, 0.f, 0.f, 0.f};
    float m_prev = 0.f;
    unsigned rq[11], rk[11], rv[8]; float g_i = 0.f, g_f = 0.f;
#define ML_LOAD(c) do { const int t0_ = (c) * 64 + 8 * rg; \
        const bf16* qp_ = QKML + (rowbase + t0_) * 1024 + nh * 128 + 2 * dp; const bf16* vp_ = VML + (rowbase + t0_) * 512 + nh * 128 + 2 * dp; \
        asm volatile("" : "+v"(qp_), "+v"(vp_));     \
        _Pragma("unroll") for (int i = 0; i < 11; ++i) { const bool ok_ = t0_ - 3 + i >= 0; const bf16* p_ = ok_ ? qp_ + (i - 3) * 1024 : qp_; \
            const unsigned a_ = *(const unsigned*)(p_), b_ = *(const unsigned*)(p_ + 512); rq[i] = ok_ ? a_ : 0u; rk[i] = ok_ ? b_ : 0u; } \
        _Pragma("unroll") for (int i = 0; i < 8; ++i) rv[i] = *(const unsigned*)(vp_ + i * 512); \
        if (wid == 0) { g_i = GATES[(rowbase + (c) * 64 + lane) * 8 + nh]; g_f = GATES[(rowbase + (c) * 64 + lane) * 8 + 4 + nh]; } } while (0)
    ML_LOAD(0);
    __syncthreads();
    for (int c = 0; c < SEQ / 64; ++c) {
        const int t0 = c * 64;
        int oQ = (fr * QST + 8 * fq) * 2, oT = (fr * TST + 8 * fq) * 2, fq4 = 4 * fq, fro = fr;
        asm volatile("" : "+v"(oQ), "+v"(oT), "+v"(fq4), "+v"(fro));
        if (wid == 0) {
            float bc = g_f;
#pragma unroll
            for (int o = 1; o < 64; o <<= 1) { const float v = __shfl_up(bc, o); if (lane >= o) bc += v; }
            const float a = g_i - bc; float pm = a;
#pragma unroll
            for (int o = 1; o < 64; o <<= 1) { const float v = __shfl_up(pm, o); if (lane >= o) pm = fmaxf(pm, v); }
            const float cm = fmaxf(m_prev, pm);
            const float cm63 = __shfl(cm, 63), bend = __shfl(bc, 63);
            SC[SC_A + lane] = a; SC[SC_CM + lane] = cm; SC[SC_INTER + lane] = expf(m_prev - cm); SC[SC_EMT + lane] = expf(-(bc + cm)); SC[SC_W + lane] = expf(a - cm63);
            m_prev = bend + cm63;
        }
        __syncthreads();
        {
            float wv[8];
#pragma unroll
            for (int i = 0; i < 8; ++i) wv[i] = SC[SC_W + 8 * rg + i];
            unsigned ktw0[4], ktw1[4], vt0[4], vt1[4];
            float kprev0 = 0.f, kprev1 = 0.f;
#pragma unroll
            for (int i = 0; i < 8; ++i) {
                float q0 = bq[0], q1 = bq[1], k0 = bk[0], k1 = bk[1];
#pragma unroll
                for (int w = 0; w < 4; ++w) { q0 += bflo(rq[i + w]) * wq[w][0]; q1 += bfhi(rq[i + w]) * wq[w][1]; k0 += bflo(rk[i + w]) * wk[w][0]; k1 += bfhi(rk[i + w]) * wk[w][1]; }
                q0 = silu_f(q0); q1 = silu_f(q1); k0 = silu_f(k0) * 0.08838834764831845f; k1 = silu_f(k1) * 0.08838834764831845f;
                const int t = 8 * rg + i;
                *(LAS unsigned*)(QS + (t * QST + 2 * dp) * 2) = pk2(q0, q1);
                *(LAS unsigned*)(KS + (t * QST + 2 * dp) * 2) = pk2(k0, k1);
                const float kw0 = k0 * wv[i], kw1 = k1 * wv[i];
                if (i & 1) { ktw0[i >> 1] = pk2(kprev0, kw0); ktw1[i >> 1] = pk2(kprev1, kw1); vt0[i >> 1] = (rv[i - 1] & 0xffffu) | (rv[i] << 16); vt1[i >> 1] = (rv[i - 1] >> 16) | (rv[i] & 0xffff0000u); }
                else { kprev0 = kw0; kprev1 = kw1; }
            }
            *(LAS u32x4*)(KTW + ((2 * dp) * TST + 8 * rg) * 2) = (u32x4){ktw0[0], ktw0[1], ktw0[2], ktw0[3]};
            *(LAS u32x4*)(KTW + ((2 * dp + 1) * TST + 8 * rg) * 2) = (u32x4){ktw1[0], ktw1[1], ktw1[2], ktw1[3]};
            *(LAS u32x4*)(VT + ((2 * dp) * TST + 8 * rg) * 2) = (u32x4){vt0[0], vt0[1], vt0[2], vt0[3]};
            *(LAS u32x4*)(VT + ((2 * dp + 1) * TST + 8 * rg) * 2) = (u32x4){vt1[0], vt1[1], vt1[2], vt1[3]};
        }
        __syncthreads();
        {
            const int it = wid >> 1, is0 = 2 * (wid & 1);
            f32x4 s0 = (f32x4){0.f, 0.f, 0.f, 0.f}, s1 = s0;
            if (is0 <= it) {
#pragma unroll
                for (int ks = 0; ks < 4; ++ks) { const bf16x8 a = ldfrag(QS, QST, 16 * it, 32 * ks, oQ); s0 = MFMA16(a, ldfrag(KS, QST, 16 * is0, 32 * ks, oQ), s0);
                    if (is0 + 1 <= it) s1 = MFMA16(a, ldfrag(KS, QST, 16 * (is0 + 1), 32 * ks, oQ), s1); asm volatile("" ::: "memory"); } }
            const float a0 = SC[SC_A + 16 * is0 + fro], a1 = SC[SC_A + 16 * is0 + 16 + fro];
#pragma unroll
            for (int r = 0; r < 4; ++r) { const int t = 16 * it + fq4 + r; const float cm = SC[SC_CM + t]; const int sA = 16 * is0 + fro, sB = sA + 16;
                const float v0 = sA <= t ? s0[r] * expf(a0 - cm) : 0.f, v1 = sB <= t ? s1[r] * expf(a1 - cm) : 0.f;
                *(LAS unsigned short*)(SP + (t * TST + sA) * 2) = (unsigned short)f2bf(v0); *(LAS unsigned short*)(SP + (t * TST + sB) * 2) = (unsigned short)f2bf(v1); }
        }
        __syncthreads();
        f32x4 n1[4], n2[4], e1 = (f32x4){0.f, 0.f, 0.f, 0.f}, e2 = e1;
        const bool extra = (wid >= 1 && wid <= 4);
        {
#pragma unroll
            for (int it = 0; it < 4; ++it) { n1[it] = (f32x4){0.f, 0.f, 0.f, 0.f}; n2[it] = n1[it]; }
#pragma unroll
            for (int ks = 0; ks < 2; ++ks) { const bf16x8 bv = ldfrag(VT, TST, 16 * wid, 32 * ks, oT);
#pragma unroll
                for (int it = 0; it < 4; ++it) n1[it] = MFMA16(ldfrag(SP, TST, 16 * it, 32 * ks, oT), bv, n1[it]);
                if (extra) e1 = MFMA16(ldfrag(SP, TST, 16 * (wid - 1), 32 * ks, oT), ldfrag(VT, TST, 128, 32 * ks, oT), e1); asm volatile("" ::: "memory"); }
#pragma unroll
            for (int ks = 0; ks < 4; ++ks) { const bf16x8 bc = ldfrag(CB, CST, 16 * wid, 32 * ks, oQ);
#pragma unroll
                for (int it = 0; it < 4; ++it) n2[it] = MFMA16(ldfrag(QS, QST, 16 * it, 32 * ks, oQ), bc, n2[it]);
                if (extra) e2 = MFMA16(ldfrag(QS, QST, 16 * (wid - 1), 32 * ks, oQ), ldfrag(CB, CST, 128, 32 * ks, oQ), e2); asm volatile("" ::: "memory"); }
            if (extra && fro == 0) {
#pragma unroll
                for (int r = 0; r < 4; ++r) { const int t = 16 * (wid - 1) + fq4 + r; SC[SC_DEN + t] = e1[r] + SC[SC_INTER + t] * e2[r]; } }
        }
        __syncthreads();
        float hv[4][4];
#pragma unroll
        for (int it = 0; it < 4; ++it)
#pragma unroll
            for (int r = 0; r < 4; ++r) { const int t = 16 * it + fq4 + r;
                const float num = n1[it][r] + SC[SC_INTER + t] * n2[it][r]; const float h = num / fmaxf(fabsf(SC[SC_DEN + t]), SC[SC_EMT + t]); hv[it][r] = h;
                float sq = h * h; sq += __shfl_xor(sq, 1); sq += __shfl_xor(sq, 2); sq += __shfl_xor(sq, 4); sq += __shfl_xor(sq, 8);
                if (fro == 0) SC[SC_HSQ + t * 8 + wid] = sq; }
        {
            const float decay = SC[SC_INTER + 63];
#pragma unroll
            for (int i = 0; i < 9; ++i) Cacc[i] = Cacc[i] * decay;
#pragma unroll
            for (int ks = 0; ks < 2; ++ks) { const bf16x8 bk8 = ldfrag(KTW, TST, 16 * wid, 32 * ks, oT);
#pragma unroll
                for (int i = 0; i < 9; ++i) Cacc[i] = MFMA16(ldfrag(VT, TST, 16 * i, 32 * ks, oT), bk8, Cacc[i]); asm volatile("" ::: "memory"); }
#pragma unroll
            for (int i = 0; i < 9; ++i)
#pragma unroll
                for (int r = 0; r < 4; ++r) *(LAS unsigned short*)(CB + ((16 * i + fq4 + r) * CST + 16 * wid + fro) * 2) = (unsigned short)f2bf(Cacc[i][r]);
        }
        unsigned short so[4][4];
#pragma unroll
        for (int it = 0; it < 4; ++it)
#pragma unroll
            for (int r = 0; r < 4; ++r) so[it][r] = OML[(rowbase + t0 + 16 * it + fq4 + r) * 512 + nh * 128 + 16 * wid + fro];
        if (c + 1 < SEQ / 64) ML_LOAD(c + 1);
        __syncthreads();
#pragma unroll
        for (int it = 0; it < 4; ++it)
#pragma unroll
            for (int r = 0; r < 4; ++r) { const int t = 16 * it + fq4 + r;
                const f32x4 pa = *(const LAS f32x4*)(SC + SC_HSQ + t * 8), pb = *(const LAS f32x4*)(SC + SC_HSQ + t * 8 + 4);
                const float ssum = ((pa[0] + pa[1]) + (pa[2] + pa[3])) + ((pb[0] + pb[1]) + (pb[2] + pb[3]));
                const float y = hv[it][r] * (1.0f / sqrtf(ssum * (1.0f / 128.0f) + RMS_EPS)) * gh * __uint_as_float((unsigned)so[it][r] << 16);
                YML[(rowbase + t0 + t) * 512 + nh * 128 + 16 * wid + fro] = (bf16)f2bf(y); }
    }
    __syncthreads();
#undef ML_LOAD
}
#undef MFMA16
}

__device__ __forceinline__ int wg_dequeue(Frame& F, gu32* head) {
    if (F.tid == 0) F.MISC[16] = __hip_atomic_fetch_add(head, 1u, RLX_AGENT);
    __syncthreads();
    const int v = (int)F.MISC[16];
    __syncthreads();
    return v;
}

__device__ __forceinline__ void mixer_phase(Frame& F, const Ptrs& P) {
    unsigned char* ws = P.ws;
    if ((int)blockIdx.x < BATCH * MLH) mlst::chain((int)blockIdx.x / MLH, (int)blockIdx.x % MLH, P, F.lds + RING_OFF);
    for (;;) {
        const int u = wg_dequeue(F, F.ctl + CW_QUEUE);
        if (u >= BATCH * SBH * 16) break;
        const int qb = 15 - (u >> 6), bh = u & 63;
        sbat::sb_unit(bh >> 3, bh & 7, qb, (const bf16*)(ws + WS_QSB), (const bf16*)(ws + WS_KSB), (const bf16*)(ws + WS_VSB), (bf16*)(ws + WS_YSB), F.lds + RING_OFF);
    }
}
#ifndef MK_PH_HI
#define MK_PH_HI 11
#endif
#ifndef MK_PER_PHASE
#define MK_PER_PHASE 0
#endif
constexpr int N_PHASES = 11;
struct Args { const float* in[21]; float* out; unsigned char* ws; int ph_lo, ph_hi; };

__global__ void __launch_bounds__(NWAVES * 64, 2) mk_fwd(Args args) {
    extern __shared__ __attribute__((aligned(16))) unsigned char lds[];
    Frame F;
    F.lds = (LAS unsigned char*)lds;
    F.MISC = (volatile LAS unsigned*)(F.lds + MISC_OFF);
    F.tid = threadIdx.x; F.lane = F.tid & 63; F.wave = __builtin_amdgcn_readfirstlane(F.tid >> 6);
    F.G = gridDim.x; { const int bx = blockIdx.x; F.vcu = (F.G % 8 == 0) ? (bx % 8) * (F.G / 8) + bx / 8 : bx; }
    unsigned char* ws = args.ws;
    F.ctl = (gu32*)(ws + WS_CTL);
    Ptrs P;
    P.x = args.in[0]; P.p = args.in[1]; P.g_mix_pre = args.in[2]; P.w_in = args.in[3]; P.b_ig = args.in[4]; P.b_fg = args.in[5]; P.w_conv = args.in[6]; P.b_conv = args.in[7];
    P.g_head = args.in[8]; P.w_bsb = args.in[9]; P.w_bml = args.in[10]; P.w_out = args.in[11]; P.g_mix_post = args.in[12]; P.g_mlp_pre = args.in[13]; P.w_up = args.in[14]; P.w_dn = args.in[15];
    P.g_mlp_post = args.in[16]; P.g_ple_pre = args.in[17]; P.w_gate = args.in[18]; P.w_proj = args.in[19]; P.g_ple_post = args.in[20]; P.out = args.out; P.ws = ws;
    if (F.tid < 64) F.MISC[F.tid] = 0u;
    __syncthreads();
    const int lo = args.ph_lo, hi = args.ph_hi;
    XcdBarrier bar; bar.bar = (unsigned*)(F.ctl + CW_BAR); bar.x = 0; bar.st = nullptr;
    if (hi - lo > 1) bar = xcd_barrier_post((unsigned*)(F.ctl + CW_BAR), F.MISC + 8);
#define IN(k) ((k) < MK_PH_HI && lo <= (k) && (k) < hi)
#define SEAM(k) do { if (IN(k) && IN((k) + 1)) xcd_barrier(bar); } while (0)
    bf16* const XN = (bf16*)(ws + WS_XN);
    float* const SSQ = (float*)(ws + WS_SSQ); float* const RS = (float*)(ws + WS_RS);
    unsigned char* const ob = (unsigned char*)args.out;

    if (IN(0)) p0_prologue(F, P);
    SEAM(0);
    if (IN(1)) {
        pg8::Gemm g{XN, (const bf16*)(ws + WS_WIN), M, NIN, DM}; pg8::StaticOrder S; S.init(M, NIN, F.G, (int)blockIdx.x);
        pg8::EpiIn E{(bf16*)(ws + WS_QSB), (bf16*)(ws + WS_KSB), (bf16*)(ws + WS_VSB), (bf16*)(ws + WS_QKML), (bf16*)(ws + WS_VML), (bf16*)(ws + WS_OML), (bf16*)(ob + OUT_GSB), (bf16*)(ob + OUT_GML)};
        pg8::gemm_phase<pg8::EpiIn, pg8::StaticOrder, true, true>(F.lds + RING_OFF, g, S, E);
    }
    SEAM(1);
    if (IN(2)) { mixer_phase(F, P); }
    SEAM(2);
    if (IN(3)) {
        { pg8::Gemm g{(const bf16*)(ws + WS_YSB), (const bf16*)(ws + WS_WBSB), M, DM, 512}; pg8::StaticOrder S; S.init(M, DM, F.G, (int)blockIdx.x);
          pg8::EpiBranch<false> E{(bf16*)(ws + WS_MERGED), (const bf16*)(ob + OUT_GSB)};
          pg8::gemm_phase<pg8::EpiBranch<false>, pg8::StaticOrder, true, true>(F.lds + RING_OFF, g, S, E); }
        { pg8::Gemm g{(const bf16*)(ws + WS_YML), (const bf16*)(ws + WS_WBML), M, DM, 512}; pg8::StaticOrder S; S.init(M, DM, F.G, (int)blockIdx.x);
          pg8::EpiBranch<true> E{(bf16*)(ws + WS_MERGED), (const bf16*)(ob + OUT_GML)};
          pg8::gemm_phase<pg8::EpiBranch<true>, pg8::StaticOrder, true, true>(F.lds + RING_OFF, g, S, E); }
    }
    SEAM(3);
    if (IN(4)) {
        pg8::Gemm g{(const bf16*)(ws + WS_MERGED), (const bf16*)(ws + WS_WOUT), M, DM, DM}; pg8::StaticOrder S; S.init(M, DM, F.G, (int)blockIdx.x);
        pg8::EpiYssq E{(bf16*)(ws + WS_Y1), SSQ};
        pg8::gemm_phase<pg8::EpiYssq, pg8::StaticOrder, true, true>(F.lds + RING_OFF, g, S, E);
    }
    SEAM(4);
    if (IN(5)) ew_residual<true>(F, P.x, (const bf16*)(ws + WS_Y1), SSQ, P.g_mix_post, XN, RS);
    SEAM(5);
    if (IN(6)) {
        pg8::Gemm g{XN, (const bf16*)(ws + WS_WUP), M, FF, DM}; pg8::StaticOrder S; S.init(M, FF, F.G, (int)blockIdx.x);
        pg8::EpiUp E{(bf16*)(ws + WS_H), RS};
        pg8::gemm_phase<pg8::EpiUp, pg8::StaticOrder, true, true>(F.lds + RING_OFF, g, S, E);
    }
    SEAM(6);
    if (IN(7)) {
        pg8::Gemm g{(const bf16*)(ws + WS_H), (const bf16*)(ws + WS_WDN), M, DM, FF}; pg8::StaticOrder S; S.init(M, DM, F.G, (int)blockIdx.x);
        pg8::EpiYssq E{(bf16*)(ob + OUT_Y2), SSQ};
        pg8::gemm_phase<pg8::EpiYssq, pg8::StaticOrder, true, true>(F.lds + RING_OFF, g, S, E);
    }
    SEAM(7);
    if (IN(8)) ew_residual<false>(F, nullptr, (const bf16*)(ob + OUT_Y2), SSQ, P.g_mlp_post, XN, RS);
    SEAM(8);
    if (IN(9)) {
        { int kp = PLE; asm volatile("" : "+s"(kp));
          pg8::Gemm g{(const bf16*)(ws + WS_PB), (const bf16*)(ws + WS_WPROJ), M, DM, kp}; pg8::StaticOrder S; S.init(M, DM, F.G, (int)blockIdx.x);
          pg8::EpiPlain E{(bf16*)(ws + WS_PP)};
          pg8::gemm_phase<pg8::EpiPlain, pg8::StaticOrder, true, true>(F.lds + RING_OFF, g, S, E); }
        { pg8::Gemm g{XN, (const bf16*)(ws + WS_WGATE), M, DM, DM}; pg8::StaticOrder S; S.init(M, DM, F.G, (int)blockIdx.x);
          pg8::EpiPle E{(bf16*)(ws + WS_T), (const bf16*)(ws + WS_PP), RS, SSQ};
          pg8::gemm_phase<pg8::EpiPle, pg8::StaticOrder, true, true>(F.lds + RING_OFF, g, S, E); }
    }
    SEAM(9);
    if (IN(10)) ew_final(F, XN, (const bf16*)(ws + WS_T), SSQ, P.g_ple_post, args.out);
#undef IN
#undef SEAM
}

#if defined(MK_DEBUG)
static void debug_tail(void* const* d_in, float* d_out, unsigned char* d_ws, hipStream_t stream);
#endif
extern "C" void kernel_launch(void* const* d_in, const int* in_sizes, int n_in, void* d_out, int out_size, void* d_ws, size_t ws_size, hipStream_t stream) {
    static int grid = 0;
    if (grid == 0) {
        if (n_in != 21 || in_sizes[0] != M * DM || out_size != M * DM || ws_size < WS_END) { fprintf(stderr, "kernel_launch: unexpected shapes (n_in %d, in0 %d, out %d, ws %zu); nothing launched\n", n_in, n_in > 0 ? in_sizes[0] : -1, out_size, ws_size); grid = -1; return; }
        int dev = 0, cus = 0, per_cu = 0;
        if (hipGetDevice(&dev) != hipSuccess || hipDeviceGetAttribute(&cus, hipDeviceAttributeMultiprocessorCount, dev) != hipSuccess) { grid = -1; return; }
        if (hipFuncSetAttribute((const void*)mk_fwd, hipFuncAttributeMaxDynamicSharedMemorySize, LDS_BYTES) != hipSuccess) { fprintf(stderr, "kernel_launch: hipFuncSetAttribute failed\n"); grid = -1; return; }
        if (hipOccupancyMaxActiveBlocksPerMultiprocessor(&per_cu, (const void*)mk_fwd, NWAVES * 64, LDS_BYTES) != hipSuccess || per_cu < 1)
            fprintf(stderr, "kernel_launch: note: occupancy query reports %d workgroups per CU\n", per_cu);
        (void)hipGetLastError();
        grid = cus;
    }
    if (grid < 0) return;
    if (hipMemsetAsync((char*)d_ws + WS_CTL, 0, CTL_ZERO_BYTES, stream) != hipSuccess) { fprintf(stderr, "kernel_launch: hipMemsetAsync failed\n"); return; }
    Args a{};
    for (int i = 0; i < 21; ++i) a.in[i] = (const float*)d_in[i];
    a.out = (float*)d_out; a.ws = (unsigned char*)d_ws;
#if MK_PER_PHASE
    for (int ph = 0; ph < MK_PH_HI; ++ph) { a.ph_lo = ph; a.ph_hi = ph + 1; hipLaunchKernelGGL(mk_fwd, dim3(grid), dim3(NWAVES * 64), LDS_BYTES, stream, a); }
#else
    a.ph_lo = 0; a.ph_hi = MK_PH_HI;
    hipLaunchKernelGGL(mk_fwd, dim3(grid), dim3(NWAVES * 64), LDS_BYTES, stream, a);
#endif
    const hipError_t le = hipPeekAtLastError();
    if (le != hipSuccess) fprintf(stderr, "kernel_launch: launch failed: %s\n", hipGetErrorName(le));
#if defined(MK_DEBUG)
    debug_tail(d_in, (float*)d_out, (unsigned char*)d_ws, stream);
#endif
}
```

```cpp
#define MK_SB_SPLIT 1024
#include <hip/hip_runtime.h>
#include <cstdio>
#include <cstdint>
#include <cmath>
namespace pg8 {
#define PG8_LAS __attribute__((address_space(3)))
typedef unsigned short bf16_t;
typedef short bf16x8 __attribute__((ext_vector_type(8)));
typedef float f32x4 __attribute__((ext_vector_type(4)));
typedef unsigned u32x4 __attribute__((ext_vector_type(4)));
constexpr int BM = 256, BK = 64, HALF = 128, HTB = HALF * BK * 2  , STAGE_BYTES = 8 * HTB, NXCD = 8, WGM = 8;

__host__ __device__ __forceinline__ int lds_byte(int r, int c) { const int st = (r >> 4) * 2 + (c >> 5), rr = r & 15, cc = c & 31, ob = rr * 64 + cc * 2; return st * 1024 + (ob ^ (((ob >> 9) & 1) << 5)); }
__host__ __device__ __forceinline__ void stage_rc(int b, int& R, int& C) { const int st = b / 1024, sb = b % 1024, swz = sb ^ (((sb >> 9) & 1) << 5); R = (st >> 1) * 16 + swz / 64; C = (st & 1) * 32 + (swz % 64) / 2; }
__host__ __device__ __forceinline__ int perm32(int rho) { const int n = rho >> 4, i = rho & 15; return 8 * (i >> 2) + 4 * n + (i & 3); }

struct Unit { int pm, pn; };
struct Gemm { const bf16_t* A; const bf16_t* Bt; int M, N, K; };

struct StaticOrder {
    int nM, nN, nwg, G, c;
    __host__ __device__ void init(int M, int N, int G_, int c_) { nM = M / BM; nN = N / BM; nwg = nM * nN; G = G_; c = c_; }
    __host__ __device__ bool next(int i, Unit& u) const {
        const long L = (long)i * G + c; if (L >= nwg) return false;
        int wgid = (int)L; { const int q = nwg / NXCD, r = nwg % NXCD, xcd = wgid % NXCD, off = wgid / NXCD; wgid = (xcd < r ? xcd * (q + 1) : r * (q + 1) + (xcd - r) * q) + off; }
        const int nig = WGM * nN, gid = wgid / nig, fm = gid * WGM, gsz = (nM - fm) < WGM ? (nM - fm) : WGM;
        u.pm = fm + ((wgid % nig) % gsz); u.pn = (wgid % nig) / gsz; return true;
    }
    __device__ __forceinline__ void a_ready(const Unit&) const {}
    __device__ __forceinline__ void done(const Unit&) const {}
};
__device__ __forceinline__ unsigned cvt_pk_bf16(float lo, float hi) { unsigned r; asm volatile("v_cvt_pk_bf16_f32 %0, %1, %2" : "=v"(r) : "v"(lo), "v"(hi)); return r; }
__device__ __forceinline__ float sigmoid_fast(float x) { return __builtin_amdgcn_rcpf(1.0f + __builtin_amdgcn_exp2f(-1.4426950408889634f * x)); }
__device__ __forceinline__ u32x4 pack8(f32x4 v0, f32x4 v1) { u32x4 w; w.x = cvt_pk_bf16(v0[0], v0[1]); w.y = cvt_pk_bf16(v0[2], v0[3]); w.z = cvt_pk_bf16(v1[0], v1[1]); w.w = cvt_pk_bf16(v1[2], v1[3]); return w; }
__device__ __forceinline__ float bf_lo(unsigned w) { return __uint_as_float(w << 16); }
__device__ __forceinline__ float bf_hi(unsigned w) { return __uint_as_float(w & 0xffff0000u); }
__device__ __forceinline__ void unpack8(u32x4 w, f32x4& v0, f32x4& v1) { v0 = (f32x4){bf_lo(w.x), bf_hi(w.x), bf_lo(w.y), bf_hi(w.y)}; v1 = (f32x4){bf_lo(w.z), bf_hi(w.z), bf_lo(w.w), bf_hi(w.w)}; }

constexpr float SBQ_SCALE = 0.125f * 1.4426950408889634f;
struct EpiIn {
    static constexpr bool PERM = true, AFTER_DRAIN = false;
    bf16_t *qsb, *ksb, *vsb, *qkml, *vml, *oml, *gsb, *gml;
    __device__ __forceinline__ void operator()(const f32x4 (&acc)[2][2][4][2], const Unit& u, int wr, int wc, int fr, int fq) const {
        const int pn = u.pn; bf16_t* base; int ld, colt, mode = 0;
        if (pn < 2) { base = qsb; ld = 512; colt = pn * 256; mode = 1; }
        else if (pn < 4) { base = ksb; ld = 512; colt = (pn - 2) * 256; }
        else if (pn < 6) { base = vsb; ld = 512; colt = (pn - 4) * 256; }
        else if (pn < 10) { base = qkml; ld = 1024; colt = (pn - 6) * 256; }
        else if (pn < 12) { base = vml; ld = 512; colt = (pn - 10) * 256; }
        else if (pn < 14) { base = oml; ld = 512; colt = (pn - 12) * 256; mode = 2; }
        else if (pn < 18) { base = gsb; ld = 1024; colt = (pn - 14) * 256; mode = 2; }
        else { base = gml; ld = 1024; colt = (pn - 18) * 256; mode = 2; }
        const int row0 = u.pm * BM + wr * 64 + fr, col0 = colt + wc * 32 + 8 * fq;
#pragma unroll
        for (int ai = 0; ai < 2; ++ai)
#pragma unroll
            for (int m = 0; m < 4; ++m) { bf16_t* rowp = base + (size_t)(row0 + ai * HALF + m * 16) * ld + col0;
#pragma unroll
                for (int bj = 0; bj < 2; ++bj) { f32x4 v0 = acc[ai][bj][m][0], v1 = acc[ai][bj][m][1];
                    if (mode == 1) { v0 = v0 * SBQ_SCALE; v1 = v1 * SBQ_SCALE; }
                    if (mode == 2) {
#pragma unroll
                        for (int e = 0; e < 4; ++e) { v0[e] = sigmoid_fast(v0[e]); v1[e] = sigmoid_fast(v1[e]); } }
                    *(u32x4*)(rowp + bj * HALF) = pack8(v0, v1); } }
    }
};
template <bool ADD> struct EpiBranch {
    static constexpr bool PERM = true, AFTER_DRAIN = false;
    bf16_t* O; const bf16_t* G;
    __device__ __forceinline__ void operator()(const f32x4 (&acc)[2][2][4][2], const Unit& u, int wr, int wc, int fr, int fq) const {
        const int row0 = u.pm * BM + wr * 64 + fr, col0 = u.pn * BM + wc * 32 + 8 * fq;
#pragma unroll
        for (int ai = 0; ai < 2; ++ai)
#pragma unroll
            for (int m = 0; m < 4; ++m) { const size_t off = (size_t)(row0 + ai * HALF + m * 16) * 1024 + col0;
#pragma unroll
                for (int bj = 0; bj < 2; ++bj) { f32x4 g0, g1; unpack8(*(const u32x4*)(G + off + bj * HALF), g0, g1);
                    f32x4 v0 = acc[ai][bj][m][0] * g0, v1 = acc[ai][bj][m][1] * g1;
                    if (ADD) { f32x4 p0, p1; unpack8(*(const u32x4*)(O + off + bj * HALF), p0, p1); v0 = v0 + p0; v1 = v1 + p1; }
                    *(u32x4*)(O + off + bj * HALF) = pack8(v0, v1); }
                asm volatile("" ::: "memory"); }
    }
};
struct EpiYssq {
    static constexpr bool PERM = true, AFTER_DRAIN = false;
    bf16_t* O; float* ssq;
    __device__ __forceinline__ void operator()(const f32x4 (&acc)[2][2][4][2], const Unit& u, int wr, int wc, int fr, int fq) const {
        const int row0 = u.pm * BM + wr * 64 + fr, col0 = u.pn * BM + wc * 32 + 8 * fq;
#pragma unroll
        for (int ai = 0; ai < 2; ++ai)
#pragma unroll
            for (int m = 0; m < 4; ++m) { const int row = row0 + ai * HALF + m * 16; const size_t off = (size_t)row * 1024 + col0; float s = 0.f;
#pragma unroll
                for (int bj = 0; bj < 2; ++bj) { const f32x4 v0 = acc[ai][bj][m][0], v1 = acc[ai][bj][m][1];
                    s += (v0[0] * v0[0] + v0[1] * v0[1]) + (v0[2] * v0[2] + v0[3] * v0[3]) + (v1[0] * v1[0] + v1[1] * v1[1]) + (v1[2] * v1[2] + v1[3] * v1[3]);
                    *(u32x4*)(O + off + bj * HALF) = pack8(v0, v1); }
                s += __shfl_xor(s, 16); s += __shfl_xor(s, 32);
                if (fq == 0) ssq[(size_t)row * 16 + u.pn * 4 + wc] = s; }
    }
};
struct EpiUp {
    static constexpr bool PERM = true, AFTER_DRAIN = false;
    bf16_t* O; const float* rs;
    __device__ __forceinline__ void operator()(const f32x4 (&acc)[2][2][4][2], const Unit& u, int wr, int wc, int fr, int fq) const {
        const int row0 = u.pm * BM + wr * 64 + fr, col0 = u.pn * BM + wc * 32 + 8 * fq;
#pragma unroll
        for (int ai = 0; ai < 2; ++ai)
#pragma unroll
            for (int m = 0; m < 4; ++m) { const int row = row0 + ai * HALF + m * 16; const float r = rs[row]; const size_t off = (size_t)row * 4096 + col0;
#pragma unroll
                for (int bj = 0; bj < 2; ++bj) { f32x4 v0 = acc[ai][bj][m][0] * r, v1 = acc[ai][bj][m][1] * r;
#pragma unroll
                    for (int e = 0; e < 4; ++e) { const float a = fmaxf(v0[e], 0.f), b = fmaxf(v1[e], 0.f); v0[e] = a * a; v1[e] = b * b; }
                    *(u32x4*)(O + off + bj * HALF) = pack8(v0, v1); } }
    }
};
struct EpiPlain {
    static constexpr bool PERM = true, AFTER_DRAIN = false;
    bf16_t* O;
    __device__ __forceinline__ void operator()(const f32x4 (&acc)[2][2][4][2], const Unit& u, int wr, int wc, int fr, int fq) const {
        const int row0 = u.pm * BM + wr * 64 + fr, col0 = u.pn * BM + wc * 32 + 8 * fq;
#pragma unroll
        for (int ai = 0; ai < 2; ++ai)
#pragma unroll
            for (int m = 0; m < 4; ++m) { const size_t off = (size_t)(row0 + ai * HALF + m * 16) * 1024 + col0;
#pragma unroll
                for (int bj = 0; bj < 2; ++bj) *(u32x4*)(O + off + bj * HALF) = pack8(acc[ai][bj][m][0], acc[ai][bj][m][1]); }
    }
};
struct EpiPle {
    static constexpr bool PERM = true, AFTER_DRAIN = false;
    bf16_t* O; const bf16_t* PP; const float* rs; float* ssq;
    __device__ __forceinline__ void operator()(const f32x4 (&acc)[2][2][4][2], const Unit& u, int wr, int wc, int fr, int fq) const {
        const int row0 = u.pm * BM + wr * 64 + fr, col0 = u.pn * BM + wc * 32 + 8 * fq;
#pragma unroll
        for (int ai = 0; ai < 2; ++ai)
#pragma unroll
            for (int m = 0; m < 4; ++m) { const int row = row0 + ai * HALF + m * 16; const float r = rs[row]; const size_t off = (size_t)row * 1024 + col0; float s = 0.f;
#pragma unroll
                for (int bj = 0; bj < 2; ++bj) { f32x4 p0, p1; unpack8(*(const u32x4*)(PP + off + bj * HALF), p0, p1);
                    f32x4 v0 = acc[ai][bj][m][0] * r, v1 = acc[ai][bj][m][1] * r;
#pragma unroll
                    for (int e = 0; e < 4; ++e) { v0[e] = sigmoid_fast(v0[e]) * p0[e]; v1[e] = sigmoid_fast(v1[e]) * p1[e]; }
                    s += (v0[0] * v0[0] + v0[1] * v0[1]) + (v0[2] * v0[2] + v0[3] * v0[3]) + (v1[0] * v1[0] + v1[1] * v1[1]) + (v1[2] * v1[2] + v1[3] * v1[3]);
                    *(u32x4*)(O + off + bj * HALF) = pack8(v0, v1); }
                s += __shfl_xor(s, 16); s += __shfl_xor(s, 32);
                if (fq == 0) ssq[(size_t)row * 16 + u.pn * 4 + wc] = s;
                asm volatile("" ::: "memory"); }
    }
};
template <class Epi, class Sched, bool ALIGN_EPI = false, bool SP2 = false>
__device__ __forceinline__ void gemm_phase(PG8_LAS unsigned char* lds, const Gemm g, const Sched& S, const Epi& E) {
    const int tid = threadIdx.x, wid = __builtin_amdgcn_readfirstlane(tid >> 6), lane = tid & 63, wr = wid >> 2, wc = wid & 3, fr = lane & 15, fq = lane >> 4;
    const int K = g.K, nt = K / BK;
    unsigned voffA[2], voffB[2];
#pragma unroll
    for (int i = 0; i < 2; ++i) { int R, C; stage_rc(tid * 16 + i * 8192, R, C); const int Rb = Epi::PERM ? ((R & ~31) + perm32(R & 31)) : R;
        voffA[i] = (unsigned)(R * K + C) * 2u; voffB[i] = (unsigned)(Rb * K + C) * 2u; }
    const size_t kstep = (size_t)(BK * 2);
    const size_t hstep = (size_t)HALF * K * 2;
    const size_t tstep = 2 * hstep;
    const unsigned ldsw = (unsigned)wid * 1024u;
    const int aoff = lds_byte(wr * 64 + fr, fq * 8), boff = lds_byte(wc * 32 + fr, fq * 8);
#define PG8_SA(b, h) (((b) * 2 + (h)) * HTB)
#define PG8_SB(b, h) ((4 + (b) * 2 + (h)) * HTB)
#define PG8_STAGE(bufoff, gbase, voff) do { _Pragma("unroll") for (int _i = 0; _i < 2; ++_i) \
        __builtin_amdgcn_global_load_lds((const unsigned*)((const char*)(gbase) + (voff)[_i]), (PG8_LAS unsigned*)(lds + (bufoff) + ldsw + _i * 8192), 16, 0, 0); } while (0)
#define PG8_LDA(dst, b, h) do { _Pragma("unroll") for (int m = 0; m < 4; ++m) _Pragma("unroll") for (int k = 0; k < 2; ++k) dst[m][k] = *(const PG8_LAS bf16x8*)(lds + PG8_SA(b, h) + aoff + m * 2048 + k * 1024); } while (0)
#define PG8_LDB(dst, b, h) do { _Pragma("unroll") for (int n = 0; n < 2; ++n) _Pragma("unroll") for (int k = 0; k < 2; ++k) dst[n][k] = *(const PG8_LAS bf16x8*)(lds + PG8_SB(b, h) + boff + n * 2048 + k * 1024); } while (0)
#define PG8_MMA(ai, bj, At, Bt) do { __builtin_amdgcn_s_setprio(1); _Pragma("unroll") for (int m = 0; m < 4; ++m) _Pragma("unroll") for (int n = 0; n < 2; ++n) _Pragma("unroll") for (int k = 0; k < 2; ++k) \
        acc[ai][bj][m][n] = __builtin_amdgcn_mfma_f32_16x16x32_bf16(Bt[n][k], At[m][k], acc[ai][bj][m][n], 0, 0, 0); __builtin_amdgcn_s_setprio(0); } while (0)
#define PG8_WAIT_V(n) asm volatile("s_waitcnt vmcnt(" #n ")" ::: "memory")
#define PG8_WAIT_L(n) asm volatile("s_waitcnt lgkmcnt(" #n ")" ::: "memory")
#define PG8_BAR __builtin_amdgcn_s_barrier()
#define PG8_SCHED __builtin_amdgcn_sched_barrier(0)
    Unit cur, nxt; int ui = 0;
    if (!S.next(0, cur)) return;
    f32x4 acc[2][2][4][2];
#pragma unroll
    for (int a = 0; a < 2; ++a)
#pragma unroll
        for (int b = 0; b < 2; ++b)
#pragma unroll
            for (int m = 0; m < 4; ++m)
#pragma unroll
                for (int n = 0; n < 2; ++n) acc[a][b][m][n] = (f32x4){0.f, 0.f, 0.f, 0.f};
    bf16x8 At[4][2], B0[2][2], B1[2][2];
    const char* cA = (const char*)g.A + (size_t)cur.pm * tstep; const char* cB = (const char*)g.Bt + (size_t)cur.pn * tstep;
    S.a_ready(cur);
    if constexpr (SP2) {
        PG8_STAGE(PG8_SB(0, 0), cB, voffB); PG8_STAGE(PG8_SB(0, 1), cB + hstep, voffB); PG8_STAGE(PG8_SA(0, 0), cA, voffA); PG8_STAGE(PG8_SA(0, 1), cA + hstep, voffA);
        if (wr == 1) PG8_BAR;
        PG8_WAIT_V(2); PG8_BAR;
        PG8_STAGE(PG8_SB(1, 0), cB + kstep, voffB); PG8_STAGE(PG8_SA(1, 0), cA + kstep, voffA); PG8_STAGE(PG8_SB(1, 1), cB + hstep + kstep, voffB);
        PG8_WAIT_V(6); PG8_BAR;
    } else {
        PG8_STAGE(PG8_SB(0, 0), cB, voffB); PG8_STAGE(PG8_SA(0, 0), cA, voffA); PG8_STAGE(PG8_SB(0, 1), cB + hstep, voffB); PG8_STAGE(PG8_SA(0, 1), cA + hstep, voffA);
        if (wr == 1) PG8_BAR;
        PG8_WAIT_V(4); PG8_BAR;
        PG8_STAGE(PG8_SB(1, 0), cB + kstep, voffB); PG8_STAGE(PG8_SA(1, 0), cA + kstep, voffA); PG8_STAGE(PG8_SB(1, 1), cB + hstep + kstep, voffB);
        PG8_WAIT_V(6); PG8_BAR;
    }
    for (;;) {
        const bool has_next = S.next(ui + 1, nxt);
        const char* nA = has_next ? (const char*)g.A + (size_t)nxt.pm * tstep : cA; const char* nB = has_next ? (const char*)g.Bt + (size_t)nxt.pn * tstep : cB;
        for (int t = 0; t < nt; t += 2) {
            const bool last = (t == nt - 2);
            const char* a1 = cA + (size_t)(t + 1) * kstep;
            const char* a2 = last ? nA : cA + (size_t)(t + 2) * kstep; const char* b2 = last ? nB : cB + (size_t)(t + 2) * kstep;
            const char* a3 = a2 + kstep; const char* b3 = b2 + kstep;
            if (last && has_next) S.a_ready(nxt);
            if constexpr (SP2) {
            PG8_LDB(B0, 0, 0); PG8_LDB(B1, 0, 1); PG8_SCHED; PG8_LDA(At, 0, 0); PG8_STAGE(PG8_SA(1, 1), a1 + hstep, voffA);
            PG8_WAIT_V(8); PG8_WAIT_L(0); PG8_BAR; PG8_MMA(0, 0, At, B0); PG8_MMA(0, 1, At, B1); PG8_BAR; PG8_SCHED;
            PG8_LDA(At, 0, 1); PG8_STAGE(PG8_SB(0, 0), b2, voffB); PG8_STAGE(PG8_SB(0, 1), b2 + hstep, voffB); PG8_STAGE(PG8_SA(0, 0), a2, voffA);
            PG8_WAIT_V(8); PG8_WAIT_L(0); PG8_BAR; PG8_MMA(1, 0, At, B0); PG8_MMA(1, 1, At, B1); PG8_BAR; PG8_SCHED;
            PG8_LDB(B0, 1, 0); PG8_LDB(B1, 1, 1); PG8_SCHED; PG8_LDA(At, 1, 0); PG8_STAGE(PG8_SA(0, 1), a2 + hstep, voffA);
            PG8_WAIT_V(8); PG8_WAIT_L(0); PG8_BAR; PG8_MMA(0, 0, At, B0); PG8_MMA(0, 1, At, B1); PG8_BAR; PG8_SCHED;
            PG8_LDA(At, 1, 1); PG8_STAGE(PG8_SB(1, 0), b3, voffB); PG8_STAGE(PG8_SB(1, 1), b3 + hstep, voffB); PG8_STAGE(PG8_SA(1, 0), a3, voffA);
            PG8_WAIT_V(8); PG8_WAIT_L(0); PG8_BAR; PG8_MMA(1, 0, At, B0); PG8_MMA(1, 1, At, B1); PG8_BAR; PG8_SCHED;
            } else {
            PG8_LDB(B0, 0, 0); PG8_SCHED; PG8_LDA(At, 0, 0); PG8_STAGE(PG8_SA(1, 1), a1 + hstep, voffA);
            PG8_WAIT_L(8); PG8_BAR; PG8_WAIT_L(0); PG8_MMA(0, 0, At, B0); PG8_BAR; PG8_SCHED;
            PG8_LDB(B1, 0, 1); PG8_STAGE(PG8_SB(0, 0), b2, voffB);
            PG8_BAR; PG8_WAIT_L(0); PG8_MMA(0, 1, At, B1); PG8_BAR;
            PG8_LDA(At, 0, 1); PG8_STAGE(PG8_SA(0, 0), a2, voffA);
            PG8_BAR; PG8_WAIT_L(0); PG8_MMA(1, 0, At, B0); PG8_BAR; PG8_SCHED;
            PG8_STAGE(PG8_SB(0, 1), b2 + hstep, voffB);
            PG8_WAIT_V(6); PG8_BAR; PG8_MMA(1, 1, At, B1); PG8_BAR;
            PG8_LDB(B0, 1, 0); PG8_SCHED; PG8_LDA(At, 1, 0); PG8_STAGE(PG8_SA(0, 1), a2 + hstep, voffA);
            PG8_WAIT_L(8); PG8_BAR; PG8_WAIT_L(0); PG8_MMA(0, 0, At, B0); PG8_BAR; PG8_SCHED;
            PG8_LDB(B1, 1, 1); PG8_STAGE(PG8_SB(1, 0), b3, voffB);
            PG8_BAR; PG8_WAIT_L(0); PG8_MMA(0, 1, At, B1); PG8_BAR;
            PG8_LDA(At, 1, 1); PG8_STAGE(PG8_SA(1, 0), a3, voffA);
            PG8_BAR; PG8_WAIT_L(0); PG8_MMA(1, 0, At, B0); PG8_BAR; PG8_SCHED;
            PG8_STAGE(PG8_SB(1, 1), b3 + hstep, voffB);
            PG8_WAIT_V(6); PG8_BAR; PG8_MMA(1, 1, At, B1); PG8_BAR;
            }
        }
        if constexpr (ALIGN_EPI) { if (wr == 0) PG8_BAR; }
        if constexpr (!Epi::AFTER_DRAIN) { E(acc, cur, wr, wc, fr, fq); S.done(cur); }
        if (!has_next) break;
#pragma unroll
        for (int a = 0; a < 2; ++a)
#pragma unroll
            for (int b = 0; b < 2; ++b)
#pragma unroll
                for (int m = 0; m < 4; ++m)
#pragma unroll
                    for (int n = 0; n < 2; ++n) acc[a][b][m][n] = (f32x4){0.f, 0.f, 0.f, 0.f};
        cur = nxt; cA = nA; cB = nB; ++ui;
        if constexpr (ALIGN_EPI) { if (wr == 1) PG8_BAR; }
    }
    PG8_WAIT_V(0);
    if constexpr (!ALIGN_EPI) { if (wr == 0) PG8_BAR; }
    PG8_BAR;
    if constexpr (Epi::AFTER_DRAIN) { E.fused(acc, cur, wr, wc, fr, fq, lds, wid, lane); S.done(cur); }
#undef PG8_SA
#undef PG8_SB
#undef PG8_STAGE
#undef PG8_LDA
#undef PG8_LDB
#undef PG8_MMA
#undef PG8_WAIT_V
#undef PG8_WAIT_L
#undef PG8_BAR
#undef PG8_SCHED
}
}
constexpr int NWAVES = 8;
constexpr int BATCH = 8, SEQ = 4096, DM = 1024, FF = 4096, PLE = 256;
constexpr int M = BATCH * SEQ;
constexpr int IN_COLS = 5640, NIN = 5632;
constexpr int COL_IF = 3584;
constexpr int SBH = 8, SBD = 64, MLH = 4, MLD = 128;
constexpr float RMS_EPS = 1e-6f;

constexpr size_t MiB = 1u << 20;
constexpr size_t WS_CTL = 0, CTL_ZERO_BYTES = 1 * MiB;
constexpr size_t WS_GATES = 1 * MiB;
constexpr size_t WS_SSQ = 2 * MiB;
constexpr size_t WS_RS = 4 * MiB;
constexpr size_t WS_WIN = 6 * MiB, WS_WBSB = 17 * MiB, WS_WBML = 18 * MiB, WS_WOUT = 19 * MiB, WS_WUP = 21 * MiB, WS_WDN = 29 * MiB, WS_WGATE = 37 * MiB, WS_WPROJ = 39 * MiB;
constexpr size_t WS_XN = 40 * MiB;
constexpr size_t WS_PB = 104 * MiB;
constexpr size_t WS_BIG = 120 * MiB;
constexpr size_t WS_QSB = WS_BIG, WS_KSB = WS_BIG + 32 * MiB, WS_VSB = WS_BIG + 64 * MiB, WS_QKML = WS_BIG + 96 * MiB, WS_VML = WS_BIG + 160 * MiB, WS_OML = WS_BIG + 192 * MiB,
                 WS_YSB = WS_BIG + 224 * MiB, WS_YML = WS_BIG + 256 * MiB;
constexpr size_t WS_MERGED = WS_BIG;
constexpr size_t WS_Y1 = WS_BIG + 96 * MiB;
constexpr size_t WS_H = WS_BIG;
constexpr size_t WS_PP = WS_BIG, WS_T = WS_BIG + 64 * MiB;
constexpr size_t WS_SUMM = 408 * MiB;
constexpr size_t WS_SUMS = 427 * MiB;
constexpr size_t WS_END = 428 * MiB;
constexpr size_t WS_DBG = 500 * MiB;
constexpr size_t OUT_GSB = 0, OUT_GML = 64 * MiB, OUT_Y2 = 0;
constexpr int CW_BAR = 4096;
constexpr int CW_QUEUE = 1024;

constexpr int RING_OFF = 0, RING_BYTES = 131072;
constexpr int LDS_BYTES = 163840;
constexpr int MISC_OFF = LDS_BYTES - 256;
#define GAS __attribute__((address_space(1)))
#define LAS __attribute__((address_space(3)))
typedef unsigned short bf16;
typedef unsigned v4u __attribute__((ext_vector_type(4)));
typedef float f32x4 __attribute__((ext_vector_type(4)));
typedef short bf16x8 __attribute__((ext_vector_type(8)));
typedef GAS unsigned gu32;
typedef GAS unsigned long long gu64;
#define RLX_AGENT __ATOMIC_RELAXED, __HIP_MEMORY_SCOPE_AGENT
#define LDS_WAIT() asm volatile("s_waitcnt lgkmcnt(0)" ::: "memory")
#define VM_WAIT() asm volatile("s_waitcnt vmcnt(0)" ::: "memory")
__device__ __forceinline__ unsigned long long rt() { return __builtin_amdgcn_s_memrealtime(); }
__device__ __forceinline__ unsigned f2bf(float f) { unsigned u = __builtin_bit_cast(unsigned, f); return (u + 0x7fffu + ((u >> 16) & 1u)) >> 16; }
__device__ __forceinline__ unsigned pk2(float lo, float hi) { return f2bf(lo) | (f2bf(hi) << 16); }

#define XB_TMO      128
#define XB_XCNT(j)  (256  + 64 * (j))
#define XB_XSUB(j)  (1280 + 64 * (j))
#define XB_XGEN(j)  (2304 + 64 * (j))
#define XB_TOP      3328
#define XB_TOPGEN   3392
#define XCD_BAR_WORDS 3456
#define XB_SPIN_CAP (1u << 18)

__device__ __forceinline__ unsigned xb_ld(unsigned* p)              { return __hip_atomic_load(p, __ATOMIC_RELAXED, __HIP_MEMORY_SCOPE_AGENT); }
__device__ __forceinline__ unsigned xb_add(unsigned* p, unsigned v) { return __hip_atomic_fetch_add(p, v, __ATOMIC_RELAXED, __HIP_MEMORY_SCOPE_AGENT); }
__device__ __forceinline__ unsigned xb_xcc_id() { return (unsigned)__builtin_amdgcn_s_getreg((3 << 11) | 20) & 0xFu; }
#define XB_SPIN(cond, bar) do { unsigned _sp = 0; while (cond) { __builtin_amdgcn_s_sleep(1); \
    if ((++_sp & 255u) == 0u) { if (xb_ld(&(bar)[XB_TMO])) break; if (_sp > XB_SPIN_CAP) { atomicAdd(&(bar)[XB_TMO], 1u); break; } } } } while (0)

struct XcdBarrier {
    unsigned* bar; unsigned x;
    volatile LAS unsigned* st;
};

__device__ __forceinline__ XcdBarrier xcd_barrier_post(unsigned* bar, volatile LAS unsigned* st) {
    XcdBarrier b; b.bar = bar; b.x = xb_xcc_id(); b.st = st;
    if (threadIdx.x == 0) (void)xb_add(&bar[XB_XCNT(b.x)], 1u);
    return b;
}
__device__ __forceinline__ void xcd_barrier_complete(unsigned* bar, unsigned x, unsigned& nloc, unsigned& nx) {
    const unsigned G = gridDim.x * gridDim.y * gridDim.z;
    unsigned sum, cnt, mine, sp = 0u;
    for (;;) {
        sum = 0u; cnt = 0u; mine = 0u;
#pragma unroll
        for (unsigned j = 0; j < 16; ++j) { const unsigned c = xb_ld(&bar[XB_XCNT(j)]); sum += c; cnt += (c > 0u) ? 1u : 0u; mine = (j == x) ? c : mine; }
        if (sum == G) break;
        __builtin_amdgcn_s_sleep(1);
        if ((++sp & 255u) == 0u) { if (xb_ld(&bar[XB_TMO])) break; if (sp > XB_SPIN_CAP) { atomicAdd(&bar[XB_TMO], 1u); break; } }
    }
    nloc = mine > 0u ? mine : 1u; nx = cnt > 0u ? cnt : 1u;
}

__device__ __forceinline__ void xcd_barrier(const XcdBarrier& b) {
    asm volatile("s_waitcnt vmcnt(0)" ::: "memory");
    __syncthreads();
    if (threadIdx.x == 0) {
        unsigned* bar = b.bar;
        __builtin_amdgcn_s_waitcnt(0);
        unsigned nloc = b.st[0], nx = b.st[1];
        if (nloc == 0u) { xcd_barrier_complete(bar, b.x, nloc, nx); b.st[0] = nloc; b.st[1] = nx; }
        const unsigned old = xb_add(&bar[XB_XSUB(b.x)], 1u);
        const unsigned gen = old / nloc;
        if (old + 1u == (gen + 1u) * nloc) {
            __builtin_amdgcn_fence(__ATOMIC_RELEASE, "agent");
            asm volatile("s_waitcnt vmcnt(0)" ::: "memory");
            const unsigned og = xb_add(&bar[XB_TOP], 1u);
            const unsigned tg = og / nx;
            if (og + 1u == (tg + 1u) * nx) xb_add(&bar[XB_TOPGEN], 1u);
            else XB_SPIN(xb_ld(&bar[XB_TOPGEN]) == tg, bar);
            __builtin_amdgcn_fence(__ATOMIC_ACQUIRE, "agent");
            xb_add(&bar[XB_XGEN(b.x)], 1u);
            asm volatile("s_waitcnt vmcnt(0)" ::: "memory");
        } else {
            XB_SPIN(xb_ld(&bar[XB_XGEN(b.x)]) == gen, bar);
            __builtin_amdgcn_fence(__ATOMIC_ACQUIRE, "agent");
            asm volatile("s_waitcnt vmcnt(0)" ::: "memory");
        }
    }
    __syncthreads();
}
struct Frame {
    LAS unsigned char* lds;
    volatile LAS unsigned* MISC;
    gu32* ctl;
    int tid, lane, wave;
    int vcu, G;
};

__device__ __forceinline__ float wave_sum(float v) {
#pragma unroll
    for (int o = 1; o < 64; o <<= 1) v += __shfl_xor(v, o);
    return v;
}
__device__ __forceinline__ float softplus_f(float x) { return fmaxf(x, 0.f) + log1pf(expf(-fabsf(x))); }
__device__ __forceinline__ void p0_transpose_item(const float* W, int ldw, int coloff, int K, int N, bf16* WT, const float* gk, LAS float* scr, int item, int lane) {
    const int nblk = N / 32, kb = item / nblk, nb = item % nblk, k0 = 64 * kb, n0 = 32 * nb;
#pragma unroll 8
    for (int i = 0; i < 32; ++i) { const int kk = 2 * i + (lane >> 5); float v = W[(size_t)(k0 + kk) * ldw + coloff + n0 + (lane & 31)]; if (gk) v *= gk[k0 + kk]; scr[kk * 33 + (lane & 31)] = v; }
    LDS_WAIT(); asm volatile("" ::: "memory");
    const int c = lane & 7;
#pragma unroll
    for (int j = 0; j < 4; ++j) { const int n = (lane >> 3) + 8 * j; const LAS float* s = scr + (8 * c) * 33 + n;
        v4u o; o.x = pk2(s[0 * 33], s[1 * 33]); o.y = pk2(s[2 * 33], s[3 * 33]); o.z = pk2(s[4 * 33], s[5 * 33]); o.w = pk2(s[6 * 33], s[7 * 33]);
        *(GAS v4u*)(WT + (size_t)(n0 + n) * K + k0 + 8 * c) = o; }
    LDS_WAIT(); asm volatile("" ::: "memory");
}

struct Ptrs {
    const float *x, *p, *g_mix_pre, *w_in, *b_ig, *b_fg, *w_conv, *b_conv, *g_head, *w_bsb, *w_bml, *w_out, *g_mix_post, *g_mlp_pre, *w_up, *w_dn, *g_mlp_post, *g_ple_pre, *w_gate, *w_proj, *g_ple_post;
    float* out; unsigned char* ws;
};

__device__ __forceinline__ void p0_prologue(Frame& F, const Ptrs& P) {
    LAS float* scr = (LAS float*)(F.lds + RING_OFF + F.wave * 16384);
    const int gw = F.vcu * NWAVES + F.wave, NGW = F.G * NWAVES;
    unsigned char* ws = P.ws;
    constexpr int I_IN = (DM / 64) * (NIN / 32), I_BS = (512 / 64) * (DM / 32), I_OUT = (DM / 64) * (DM / 32), I_UP = (DM / 64) * (FF / 32), I_DN = (FF / 64) * (DM / 32), I_PJ = (PLE / 64) * (DM / 32);
    constexpr int NITEMS = I_IN + 2 * I_BS + I_OUT + I_UP + I_DN + I_OUT + I_PJ;
    for (int it = gw; it < NITEMS; it += NGW) {
        int r = it;
        if (r < I_IN) { const int n0 = 32 * (r % (NIN / 32)); p0_transpose_item(P.w_in, IN_COLS, n0 >= COL_IF ? 8 : 0, DM, NIN, (bf16*)(ws + WS_WIN), nullptr, scr, r, F.lane); continue; } r -= I_IN;
        if (r < I_BS) { p0_transpose_item(P.w_bsb, DM, 0, 512, DM, (bf16*)(ws + WS_WBSB), nullptr, scr, r, F.lane); continue; } r -= I_BS;
        if (r < I_BS) { p0_transpose_item(P.w_bml, DM, 0, 512, DM, (bf16*)(ws + WS_WBML), nullptr, scr, r, F.lane); continue; } r -= I_BS;
        if (r < I_OUT) { p0_transpose_item(P.w_out, DM, 0, DM, DM, (bf16*)(ws + WS_WOUT), nullptr, scr, r, F.lane); continue; } r -= I_OUT;
        if (r < I_UP) { p0_transpose_item(P.w_up, FF, 0, DM, FF, (bf16*)(ws + WS_WUP), P.g_mlp_pre, scr, r, F.lane); continue; } r -= I_UP;
        if (r < I_DN) { p0_transpose_item(P.w_dn, DM, 0, FF, DM, (bf16*)(ws + WS_WDN), nullptr, scr, r, F.lane); continue; } r -= I_DN;
        if (r < I_OUT) { p0_transpose_item(P.w_gate, DM, 0, DM, DM, (bf16*)(ws + WS_WGATE), P.g_ple_pre, scr, r, F.lane); continue; } r -= I_OUT;
        p0_transpose_item(P.w_proj, DM, 0, PLE, DM, (bf16*)(ws + WS_WPROJ), nullptr, scr, r, F.lane);
    }
    { const GAS f32x4* src = (const GAS f32x4*)P.p; GAS unsigned long long* dst = (GAS unsigned long long*)(ws + WS_PB);
      const size_t n4 = (size_t)M * PLE / 4;
      for (size_t i = (size_t)gw * 64 + F.lane; i < n4; i += (size_t)NGW * 64) { const f32x4 v = src[i]; dst[i] = (unsigned long long)pk2(v.x, v.y) | ((unsigned long long)pk2(v.z, v.w) << 32); } }
    __syncthreads();
    LAS float* Wg = (LAS float*)(F.lds + RING_OFF);
    for (int e = F.tid; e < 8 * DM; e += NWAVES * 64) { const int k = e >> 3, j = e & 7; Wg[j * DM + k] = P.w_in[(size_t)k * IN_COLS + COL_IF + j]; }
    __syncthreads();
    f32x4 gm[4];
#pragma unroll
    for (int j = 0; j < 4; ++j) gm[j] = ((const GAS f32x4*)P.g_mix_pre)[F.lane + 64 * j];
    const float bias = F.lane < 4 ? P.b_ig[F.lane] : (F.lane < 8 ? P.b_fg[F.lane - 4] : 0.f);
    float* gates = (float*)(ws + WS_GATES);
    for (int m = gw; m < M; m += NGW) {
        const GAS f32x4* xr = (const GAS f32x4*)(P.x + (size_t)m * DM) + F.lane;
        f32x4 v[4]; float s = 0.f;
#pragma unroll
        for (int j = 0; j < 4; ++j) { v[j] = xr[64 * j]; s += (v[j].x * v[j].x + v[j].y * v[j].y) + (v[j].z * v[j].z + v[j].w * v[j].w); }
        const float rstd = 1.f / sqrtf(wave_sum(s) * (1.f / DM) + RMS_EPS);
#pragma unroll
        for (int j = 0; j < 4; ++j) v[j] = v[j] * rstd * gm[j];
        GAS unsigned long long* o8 = (GAS unsigned long long*)(ws + WS_XN + (size_t)m * DM * 2) + F.lane;
#pragma unroll
        for (int j = 0; j < 4; ++j) o8[64 * j] = (unsigned long long)pk2(v[j].x, v[j].y) | ((unsigned long long)pk2(v[j].z, v[j].w) << 32);
        float mine = 0.f;
#pragma unroll
        for (int g = 0; g < 8; ++g) { float a = 0.f;
#pragma unroll
            for (int j = 0; j < 4; ++j) { const f32x4 w = *(const LAS f32x4*)(Wg + g * DM + 4 * F.lane + 256 * j); a += (v[j].x * w.x + v[j].y * w.y) + (v[j].z * w.z + v[j].w * w.w); }
            a = wave_sum(a); if (F.lane == g) mine = a; }
        if (F.lane < 8) { float val = mine + bias; if (F.lane >= 4) val = -softplus_f(-val); gates[(size_t)m * 8 + F.lane] = val; }
    }
    __syncthreads();
}

template <bool XIN_F32> __device__ __forceinline__ void ew_residual(Frame& F, const float* x, const bf16* Y, const float* ssq, const float* g, bf16* XN, float* RS) {
    const int gw = F.vcu * NWAVES + F.wave, NGW = F.G * NWAVES;
    f32x4 gm[4];
#pragma unroll
    for (int j = 0; j < 4; ++j) gm[j] = ((const GAS f32x4*)g)[F.lane + 64 * j];
    for (int m = gw; m < M; m += NGW) {
        float sq = F.lane < 16 ? ssq[(size_t)m * 16 + F.lane] : 0.f;
        sq = wave_sum(sq);
        const float rstd_y = 1.f / sqrtf(sq * (1.f / DM) + RMS_EPS);
        f32x4 v[4]; float s = 0.f;
        const GAS unsigned long long* y8 = (const GAS unsigned long long*)(Y + (size_t)m * DM) + F.lane;
        GAS unsigned long long* o8 = (GAS unsigned long long*)(XN + (size_t)m * DM) + F.lane;
#pragma unroll
        for (int j = 0; j < 4; ++j) {
            f32x4 xi;
            if (XIN_F32) xi = ((const GAS f32x4*)(x + (size_t)m * DM))[F.lane + 64 * j];
            else { const unsigned long long w = o8[64 * j]; const unsigned lo = (unsigned)w, hi = (unsigned)(w >> 32); xi = (f32x4){__uint_as_float(lo << 16), __uint_as_float(lo & 0xffff0000u), __uint_as_float(hi << 16), __uint_as_float(hi & 0xffff0000u)}; }
            const unsigned long long w = y8[64 * j]; const unsigned lo = (unsigned)w, hi = (unsigned)(w >> 32);
            const f32x4 yv = (f32x4){__uint_as_float(lo << 16), __uint_as_float(lo & 0xffff0000u), __uint_as_float(hi << 16), __uint_as_float(hi & 0xffff0000u)};
            v[j] = xi + yv * rstd_y * gm[j];
            s += (v[j].x * v[j].x + v[j].y * v[j].y) + (v[j].z * v[j].z + v[j].w * v[j].w);
        }
        s = wave_sum(s);
#pragma unroll
        for (int j = 0; j < 4; ++j) o8[64 * j] = (unsigned long long)pk2(v[j].x, v[j].y) | ((unsigned long long)pk2(v[j].z, v[j].w) << 32);
        if (F.lane == 0) RS[m] = 1.f / sqrtf(s * (1.f / DM) + RMS_EPS);
    }
}
__device__ __forceinline__ void ew_final(Frame& F, const bf16* XN, const bf16* T, const float* ssq, const float* g, float* out) {
    const int gw = F.vcu * NWAVES + F.wave, NGW = F.G * NWAVES;
    f32x4 gm[4];
#pragma unroll
    for (int j = 0; j < 4; ++j) gm[j] = ((const GAS f32x4*)g)[F.lane + 64 * j];
    for (int m = gw; m < M; m += NGW) {
        float sq = F.lane < 16 ? ssq[(size_t)m * 16 + F.lane] : 0.f;
        sq = wave_sum(sq);
        const float rstd_t = 1.f / sqrtf(sq * (1.f / DM) + RMS_EPS);
        const GAS unsigned long long* t8 = (const GAS unsigned long long*)(T + (size_t)m * DM) + F.lane;
        const GAS unsigned long long* x8 = (const GAS unsigned long long*)(XN + (size_t)m * DM) + F.lane;
        GAS f32x4* o = (GAS f32x4*)(out + (size_t)m * DM) + F.lane;
#pragma unroll
        for (int j = 0; j < 4; ++j) {
            const unsigned long long wx = x8[64 * j], wt = t8[64 * j]; const unsigned xl = (unsigned)wx, xh = (unsigned)(wx >> 32), tl = (unsigned)wt, th = (unsigned)(wt >> 32);
            const f32x4 xi = (f32x4){__uint_as_float(xl << 16), __uint_as_float(xl & 0xffff0000u), __uint_as_float(xh << 16), __uint_as_float(xh & 0xffff0000u)};
            const f32x4 tv = (f32x4){__uint_as_float(tl << 16), __uint_as_float(tl & 0xffff0000u), __uint_as_float(th << 16), __uint_as_float(th & 0xffff0000u)};
            o[64 * j] = xi + tv * rstd_t * gm[j];
        }
    }
}
namespace sbat {
using bf16x8 = __attribute__((ext_vector_type(8))) short;
using s16x4 = __attribute__((ext_vector_type(4))) short;
using f32x16 = __attribute__((ext_vector_type(16))) float;
using u32x4 = __attribute__((ext_vector_type(4))) unsigned;
constexpr int PITCH = 512;
constexpr int NSLOT = 2, SLOTB = 8192;
constexpr int LDS_K = 0, LDS_V = NSLOT * SLOTB, LDS_OST = 2 * NSLOT * SLOTB, LDS_FLAG = LDS_OST + NWAVES * 4096, LDS_BYTES = LDS_FLAG + 64;
__device__ __forceinline__ int crow(int r, int hi) { return (r & 3) + 8 * (r >> 2) + 4 * hi; }
#define SBAR() __builtin_amdgcn_sched_barrier(0)
__device__ __forceinline__ void glds16(const void* gsrc, unsigned lds_dst) { unsigned keep;
    asm volatile("s_mov_b32 %0, m0\n\ts_mov_b32 m0, %2\n\ts_nop 0\n\tglobal_load_lds_dwordx4 %1, off\n\ts_mov_b32 m0, %0" : "=&s"(keep) : "v"(gsrc), "s"(lds_dst) : "memory"); }
typedef float f32x2_t __attribute__((ext_vector_type(2))); typedef __bf16 bf16x2_t __attribute__((ext_vector_type(2)));
__device__ __forceinline__ unsigned cvtpk_s(float lo, float hi) { f32x2_t v = {lo, hi}; bf16x2_t b = __builtin_convertvector(v, bf16x2_t); return __builtin_bit_cast(unsigned, b); }
#define WAIT_BAR(N) asm volatile("s_waitcnt vmcnt(" #N ") lgkmcnt(0)\n\ts_barrier" ::: "memory")
typedef __attribute__((address_space(3))) const char* lds_cptr;
__device__ __forceinline__ void pv(f32x16* o, int vb, bf16x8 pa0, bf16x8 pa1, bf16x8 pa2, bf16x8 pa3) {
#pragma unroll
    for (int d0 = 0; d0 < 2; ++d0) { s16x4 lo[4], hi[4];
#pragma unroll
        for (int ks = 0; ks < 4; ++ks) {
            asm volatile("ds_read_b64_tr_b16 %0,%1 offset:%c2" : "=&v"(lo[ks]) : "v"(vb), "i"(d0 * 4096 + ks * 1024) : "memory");
            asm volatile("ds_read_b64_tr_b16 %0,%1 offset:%c2" : "=&v"(hi[ks]) : "v"(vb), "i"(d0 * 4096 + ks * 1024 + 512) : "memory"); }
        asm volatile("s_waitcnt lgkmcnt(0)" ::: "memory"); SBAR();
#define PK(k) (bf16x8){lo[k][0], lo[k][1], lo[k][2], lo[k][3], hi[k][0], hi[k][1], hi[k][2], hi[k][3]}
        o[d0] = __builtin_amdgcn_mfma_f32_32x32x16_bf16(pa0, PK(0), o[d0], 0, 0, 0);
        o[d0] = __builtin_amdgcn_mfma_f32_32x32x16_bf16(pa1, PK(1), o[d0], 0, 0, 0);
        o[d0] = __builtin_amdgcn_mfma_f32_32x32x16_bf16(pa2, PK(2), o[d0], 0, 0, 0);
        o[d0] = __builtin_amdgcn_mfma_f32_32x32x16_bf16(pa3, PK(3), o[d0], 0, 0, 0);
#undef PK
    }
}
template <bool MASKED> __device__ __forceinline__ void sb_tile_math(f32x16& p0, f32x16& p1, float& R, int qrel, int hi, u32x4& pw0, u32x4& pw1, u32x4& pw2, u32x4& pw3) {
    f32x16 k0, k1;
#pragma unroll
    for (int r = 0; r < 16; ++r) {
        float e0 = __builtin_amdgcn_exp2f(fminf(p0[r], 86.0f)), e1 = __builtin_amdgcn_exp2f(fminf(p1[r], 86.0f));
        float c0 = __builtin_amdgcn_rcpf(1.0f + e0), c1 = __builtin_amdgcn_rcpf(1.0f + e1);
        if (MASKED) { const int kk = crow(r, hi); if (kk >= qrel) { e0 = 0.f; c0 = 1.f; } if (kk + 32 >= qrel) { e1 = 0.f; c1 = 1.f; } }
        p0[r] = e0; p1[r] = e1; k0[r] = c0; k1[r] = c1;
    }
    float glo0[4], ghi0[4], glo1[4], ghi1[4];
#pragma unroll
    for (int g = 0; g < 4; ++g) {
        const float a = (k0[4 * g] * k0[4 * g + 1]) * (k0[4 * g + 2] * k0[4 * g + 3]), b = (k1[4 * g] * k1[4 * g + 1]) * (k1[4 * g + 2] * k1[4 * g + 3]);
        auto ra = __builtin_amdgcn_permlane32_swap(__float_as_uint(a), __float_as_uint(a), false, false);
        auto rb = __builtin_amdgcn_permlane32_swap(__float_as_uint(b), __float_as_uint(b), false, false);
        glo0[g] = __uint_as_float(ra[0]); ghi0[g] = __uint_as_float(ra[1]); glo1[g] = __uint_as_float(rb[0]); ghi1[g] = __uint_as_float(rb[1]);
    }
    float c = R;
    float st1[4], st0[4];
#pragma unroll
    for (int g = 3; g >= 0; --g) { const float sh = c; c *= ghi1[g]; const float sl = c; c *= glo1[g]; st1[g] = hi ? sh : sl; }
#pragma unroll
    for (int g = 3; g >= 0; --g) { const float sh = c; c *= ghi0[g]; const float sl = c; c *= glo0[g]; st0[g] = hi ? sh : sl; }
    R = c;
#pragma unroll
    for (int g = 0; g < 4; ++g) {
        float s1 = st1[g], s0 = st0[g];
#pragma unroll
        for (int i = 3; i >= 0; --i) { s1 *= k1[4 * g + i]; p1[4 * g + i] *= s1; s0 *= k0[4 * g + i]; p0[4 * g + i] *= s0; }
    }
    pw0 = (u32x4){cvtpk_s(p0[0], p0[1]), cvtpk_s(p0[2], p0[3]), cvtpk_s(p0[4], p0[5]), cvtpk_s(p0[6], p0[7])};
    pw1 = (u32x4){cvtpk_s(p0[8], p0[9]), cvtpk_s(p0[10], p0[11]), cvtpk_s(p0[12], p0[13]), cvtpk_s(p0[14], p0[15])};
    pw2 = (u32x4){cvtpk_s(p1[0], p1[1]), cvtpk_s(p1[2], p1[3]), cvtpk_s(p1[4], p1[5]), cvtpk_s(p1[6], p1[7])};
    pw3 = (u32x4){cvtpk_s(p1[8], p1[9]), cvtpk_s(p1[10], p1[11]), cvtpk_s(p1[12], p1[13]), cvtpk_s(p1[14], p1[15])};
}

__device__ __forceinline__ void sb_unit(int b, int h, int qb, const bf16* Q, const bf16* K, const bf16* V, bf16* O, LAS unsigned char* lds) {
    const int tid = threadIdx.x, lane = tid & 63, r32 = lane & 31, hi = lane >> 5; const int wid = __builtin_amdgcn_readfirstlane(tid >> 6);
    const long rowbase = (long)b * SEQ; const int q0 = qb * 256, tw = q0 + wid * 32;
    const bf16* Qw = Q + (rowbase + tw) * PITCH + h * SBD;
    const bf16* Kh = K + rowbase * PITCH + h * SBD; const bf16* Vh = V + rowbase * PITCH + h * SBD;
    const unsigned lds0 = (unsigned)(uintptr_t)lds;
    const bf16* ksrc = Kh + (long)lane * PITCH + wid * 8;
    const bf16* vsrc = Vh + (long)(16 * (wid & 3) + (lane >> 2)) * PITCH + (wid >> 2) * 32 + (lane & 3) * 8;
    const unsigned kdst = lds0 + LDS_K + wid * 1024, vdst = lds0 + LDS_V + wid * 1024;
#define DMA_K(t, slot) glds16(ksrc + (long)(t) * 64 * PITCH, (unsigned)__builtin_amdgcn_readfirstlane(kdst + (slot)))
#define DMA_V(t, slot) glds16(vsrc + (long)(t) * 64 * PITCH, (unsigned)__builtin_amdgcn_readfirstlane(vdst + (slot)))
    const int vb0 = (int)(lds0 + LDS_V) + ((lane >> 4) & 1) * 32 + (lane & 3) * 8 + (4 * hi + ((lane & 15) >> 2)) * 64;
    const lds_cptr kp0 = (lds_cptr)lds + LDS_K + hi * 1024 + r32 * 16;
    const int NT = (q0 + 256) / 64;
    LAS unsigned* flags = (LAS unsigned*)(lds + LDS_FLAG);
    DMA_K(NT - 1, 0); DMA_V(NT - 1, 0);
    bf16x8 qr[4];
#pragma unroll
    for (int d0 = 0; d0 < 4; ++d0) qr[d0] = *reinterpret_cast<const bf16x8*>(&Qw[(long)r32 * PITCH + d0 * 16 + hi * 8]);
    f32x16 o[2]; o[0] = f32x16{}; o[1] = f32x16{};
    float R = 1.0f;
    int slot = 0;
    for (int t = NT - 1; t >= 0; --t) {
        if (t > 0) { DMA_K(t - 1, slot ^ SLOTB); DMA_V(t - 1, slot ^ SLOTB); WAIT_BAR(2); } else { WAIT_BAR(0); }
        const int qrel = tw + r32 - 64 * t;
        if (64 * t < tw + 31) {
            f32x16 p0 = f32x16{}, p1 = f32x16{};
            const lds_cptr kb = kp0 + slot;
#pragma unroll
            for (int d0 = 0; d0 < 4; ++d0) {
                const bf16x8 b0 = *(const __attribute__((address_space(3))) bf16x8*)(kb + d0 * 2048);
                const bf16x8 b1 = *(const __attribute__((address_space(3))) bf16x8*)(kb + d0 * 2048 + 512);
                p0 = __builtin_amdgcn_mfma_f32_32x32x16_bf16(b0, qr[d0], p0, 0, 0, 0);
                p1 = __builtin_amdgcn_mfma_f32_32x32x16_bf16(b1, qr[d0], p1, 0, 0, 0);
            }
            u32x4 pw0, pw1, pw2, pw3;
            if (64 * t + 63 >= tw) sb_tile_math<true>(p0, p1, R, qrel, hi, pw0, pw1, pw2, pw3);
            else sb_tile_math<false>(p0, p1, R, qrel, hi, pw0, pw1, pw2, pw3);
            pv(o, vb0 + slot, __builtin_bit_cast(bf16x8, pw0), __builtin_bit_cast(bf16x8, pw1), __builtin_bit_cast(bf16x8, pw2), __builtin_bit_cast(bf16x8, pw3));
        }
        if (lane == 0) flags[wid] = __all(R < 1.17549435e-38f) ? 1u : 0u;
        asm volatile("s_waitcnt lgkmcnt(0)\n\ts_barrier" ::: "memory");
        { const u32x4 fa = *(const LAS u32x4*)flags, fb = *(const LAS u32x4*)(flags + 4);
          if ((fa.x & fa.y & fa.z & fa.w & fb.x & fb.y & fb.z & fb.w) != 0u) break; }
        slot ^= SLOTB;
    }
    bf16* Ow = O + (rowbase + tw) * PITCH + h * SBD;
    { LAS bf16* stg = (LAS bf16*)(lds + LDS_OST) + wid * 2048;
#pragma unroll
      for (int r = 0; r < 16; ++r) { const int orow = crow(r, hi);
#pragma unroll
          for (int d0 = 0; d0 < 2; ++d0) stg[orow * 64 + d0 * 32 + r32] = (bf16)(cvtpk_s(o[d0][r], 0.f) & 0xffffu); }
      asm volatile("s_waitcnt lgkmcnt(0)" ::: "memory");
#pragma unroll
      for (int i = 0; i < 4; ++i) { const int row = i * 8 + (lane >> 3), ch = lane & 7; const u32x4 v = *(const LAS u32x4*)(stg + row * 64 + ch * 8); *(u32x4*)(Ow + (long)row * PITCH + ch * 8) = v; } }
    asm volatile("s_waitcnt vmcnt(0) lgkmcnt(0)\n\ts_barrier" ::: "memory");
#undef DMA_K
#undef DMA_V
}
#undef SBAR
#undef WAIT_BAR
}


namespace mlst {
using bf16x8 = __attribute__((ext_vector_type(8))) short;
using f32x4 = __attribute__((ext_vector_type(4))) float;
using u32x4 = __attribute__((ext_vector_type(4))) unsigned;
constexpr int NG = 8, GC = 8;
constexpr int QST = 136, TST = 72, CST = 136;
constexpr int L_QS = 0, L_KS = 17408, L_KTW = 34816, L_VT = 53248, L_CB = 73984, L_SP = 113152, L_SC = 122368;
constexpr int SC_DEN = 0, SC_HSQ = 64, SC_MP = 576;
constexpr int L_GS = 131072;
constexpr int GS_A = 0, GS_CM = 512, GS_INTER = 1024, GS_EMT = 1536, GS_W = 2048, GS_B = 2560, GS_PM = 3072;
static_assert(L_SC + (SC_MP + 16) * 4 <= RING_BYTES && L_GS + 3584 * 4 <= MISC_OFF, "mLSTM LDS map");
constexpr size_t SUMM_BYTES = (size_t)NWAVES * 9 * 64 * 16;
__device__ __forceinline__ bf16x8 ldfrag(LAS const unsigned char* base, int stride_el, int row0, int k0, int lo) {
    return *(const LAS bf16x8*)(base + lo + (row0 * stride_el + k0) * 2); }
__device__ __forceinline__ float bflo(unsigned w) { return __uint_as_float(w << 16); }
__device__ __forceinline__ float bfhi(unsigned w) { return __uint_as_float(w & 0xffff0000u); }
__device__ __forceinline__ float silu_f(float x) { return x * __builtin_amdgcn_rcpf(1.0f + __builtin_amdgcn_exp2f(-1.4426950408889634f * x)); }
#define MFMA16(a, b, c) __builtin_amdgcn_mfma_f32_16x16x32_bf16((a), (b), (c), 0, 0, 0)
constexpr float NEG_BIG = -1.0e30f;

template <bool FULL> __device__ __forceinline__ void item(int chainid, int g, const Ptrs& P, LAS unsigned char* lds) {
    const int tid = threadIdx.x, lane = tid & 63; const int wid = __builtin_amdgcn_readfirstlane(tid >> 6);
    const int b = chainid / MLH, nh = chainid % MLH;
    unsigned char* ws = P.ws;
    const bf16* QKML = (const bf16*)(ws + WS_QKML); const bf16* VML = (const bf16*)(ws + WS_VML); const bf16* OML = (const bf16*)(ws + WS_OML); bf16* YML = (bf16*)(ws + WS_YML);
    const float* GATES = (const float*)(ws + WS_GATES);
    float* SUMS = (float*)(ws + WS_SUMS);
    LAS unsigned char* QS = lds + L_QS; LAS unsigned char* KS = lds + L_KS; LAS unsigned char* KTW = lds + L_KTW; LAS unsigned char* VT = lds + L_VT; LAS unsigned char* CB = lds + L_CB; LAS unsigned char* SP = lds + L_SP;
    LAS float* SC = (LAS float*)(lds + L_SC); LAS float* GS = (LAS float*)(lds + L_GS);
    const size_t rowbase = (size_t)b * SEQ;
    const int c0 = g * GC;
    const int dp = tid & 63, rg = wid;
    const int fr = lane & 15, fq = lane >> 4;
    for (int e = tid; e < 16 * TST / 2; e += NWAVES * 64) ((LAS unsigned*)(VT + 128 * TST * 2))[e] = (e < TST / 2) ? 0x3F803F80u : 0u;
    float wq[4][2], wk[4][2], bq[2], bk[2];
#pragma unroll
    for (int j = 0; j < 2; ++j) { const int cq = nh * 128 + 2 * dp + j, ck = 512 + cq; bq[j] = FULL ? P.b_conv[cq] : 0.f; bk[j] = P.b_conv[ck];
#pragma unroll
        for (int w = 0; w < 4; ++w) { wq[w][j] = FULL ? P.w_conv[w * 1024 + cq] : 0.f; wk[w][j] = P.w_conv[w * 1024 + ck]; } }
    const float gh = FULL ? P.g_head[nh * 128 + 16 * wid + fr] : 0.f;
    f32x4 Cacc[9];
#pragma unroll
    for (int i = 0; i < 9; ++i) Cacc[i] = (f32x4){0.f, 0.f, 0.f, 0.f};
    float m0 = NEG_BIG;
    if (FULL && g > 0) {
        float ml[NG], Bs[NG];
#pragma unroll
        for (int j = 0; j < NG; ++j) { ml[j] = j < g ? SUMS[(chainid * NG + j) * 2] : NEG_BIG; Bs[j] = j < g ? SUMS[(chainid * NG + j) * 2 + 1] : 0.f; }
        float suf = 0.f;
#pragma unroll
        for (int j = NG - 1; j >= 0; --j) { if (j < g) { ml[j] += suf; m0 = fmaxf(m0, ml[j]); suf += Bs[j]; } }
#pragma unroll
        for (int j = 0; j < NG; ++j) if (j < g) {
            const float coef = expf(ml[j] - m0);
            const GAS f32x4* src = (const GAS f32x4*)(ws + WS_SUMM + (size_t)(chainid * NG + j) * SUMM_BYTES) + (size_t)wid * 9 * 64 + lane;
#pragma unroll
            for (int i = 0; i < 9; ++i) Cacc[i] = Cacc[i] + src[i * 64] * coef;
        }
    }
    if (FULL) {
#pragma unroll
        for (int i = 0; i < 9; ++i)
#pragma unroll
            for (int r = 0; r < 4; ++r) *(LAS unsigned short*)(CB + ((16 * i + 4 * fq + r) * CST + 16 * wid + fr) * 2) = (unsigned short)f2bf(Cacc[i][r]);
    }
    {
        const size_t row = rowbase + (size_t)(c0 + wid) * 64 + lane;
        const float gi = ((const GAS float*)GATES)[row * 8 + nh], gf = ((const GAS float*)GATES)[row * 8 + 4 + nh];
        float bc = gf;
#pragma unroll
        for (int o = 1; o < 64; o <<= 1) { const float v = __shfl_up(bc, o); if (lane >= o) bc += v; }
        const float a = gi - bc; float pm = a;
#pragma unroll
        for (int o = 1; o < 64; o <<= 1) { const float v = __shfl_up(pm, o); if (lane >= o) pm = fmaxf(pm, v); }
        GS[GS_A + wid * 64 + lane] = a; GS[GS_B + wid * 64 + lane] = bc; GS[GS_PM + wid * 64 + lane] = pm;
        __syncthreads();
        if (tid == 0) { float mp = m0; float bsum = 0.f;
            for (int c = 0; c < GC; ++c) { SC[SC_MP + c] = mp; const float cm63 = fmaxf(mp, GS[GS_PM + c * 64 + 63]); const float be = GS[GS_B + c * 64 + 63]; mp = be + cm63; bsum += be; }
            SC[SC_MP + GC] = mp; SC[SC_MP + GC + 1] = bsum; }
        __syncthreads();
        const float mp = SC[SC_MP + wid];
        const float cm = fmaxf(mp, pm), cm63 = fmaxf(mp, GS[GS_PM + wid * 64 + 63]);
        GS[GS_CM + wid * 64 + lane] = cm; GS[GS_INTER + wid * 64 + lane] = expf(mp - cm); GS[GS_EMT + wid * 64 + lane] = expf(-(bc + cm)); GS[GS_W + wid * 64 + lane] = expf(a - cm63);
    }
    unsigned rq[11], rk[11], rv[8];
#define ML_LOAD(c) do { const int t0_ = (c) * 64 + 8 * rg; \
        const GAS unsigned* qp_ = (const GAS unsigned*)(QKML + (rowbase + t0_) * 1024 + nh * 128 + 2 * dp); const GAS unsigned* vp_ = (const GAS unsigned*)(VML + (rowbase + t0_) * 512 + nh * 128 + 2 * dp); \
        asm volatile("" : "+v"(qp_), "+v"(vp_));     \
        const bool first_ = (t0_ == 0);              \
        _Pragma("unroll") for (int i = 0; i < 11; ++i) { const GAS unsigned* p_ = qp_ + ((i < 3 && first_) ? 0 : (i - 3) * 512); \
            if (FULL) rq[i] = p_[0]; else rq[i] = 0u; rk[i] = p_[256]; } \
        if (first_) { rq[0] = 0u; rq[1] = 0u; rq[2] = 0u; rk[0] = 0u; rk[1] = 0u; rk[2] = 0u; } \
        _Pragma("unroll") for (int i = 0; i < 8; ++i) rv[i] = vp_[i * 256]; } while (0)
    ML_LOAD(c0);
    for (int cc = 0; cc < GC; ++cc) {
        const int c = c0 + cc, t0 = c * 64;
        int oQ = (fr * QST + 8 * fq) * 2, oT = (fr * TST + 8 * fq) * 2, fq4 = 4 * fq, fro = fr;
        asm volatile("" : "+v"(oQ), "+v"(oT), "+v"(fq4), "+v"(fro));
        LAS const float* gsc = GS + cc * 64;
        __syncthreads();
        {
            float wv[8];
#pragma unroll
            for (int i = 0; i < 8; ++i) wv[i] = gsc[GS_W + 8 * rg + i];
            unsigned ktw0[4], ktw1[4], vt0[4], vt1[4];
            float kprev0 = 0.f, kprev1 = 0.f;
#pragma unroll
            for (int i = 0; i < 8; ++i) {
                float k0 = bk[0], k1 = bk[1];
#pragma unroll
                for (int w = 0; w < 4; ++w) { k0 += bflo(rk[i + w]) * wk[w][0]; k1 += bfhi(rk[i + w]) * wk[w][1]; }
                k0 = silu_f(k0) * 0.08838834764831845f; k1 = silu_f(k1) * 0.08838834764831845f;
                const int t = 8 * rg + i;
                if (FULL) {
                    float q0 = bq[0], q1 = bq[1];
#pragma unroll
                    for (int w = 0; w < 4; ++w) { q0 += bflo(rq[i + w]) * wq[w][0]; q1 += bfhi(rq[i + w]) * wq[w][1]; }
                    q0 = silu_f(q0); q1 = silu_f(q1);
                    *(LAS unsigned*)(QS + (t * QST + 2 * dp) * 2) = pk2(q0, q1);
                    *(LAS unsigned*)(KS + (t * QST + 2 * dp) * 2) = pk2(k0, k1);
                }
                const float kw0 = k0 * wv[i], kw1 = k1 * wv[i];
                if (i & 1) { ktw0[i >> 1] = pk2(kprev0, kw0); ktw1[i >> 1] = pk2(kprev1, kw1); vt0[i >> 1] = (rv[i - 1] & 0xffffu) | (rv[i] << 16); vt1[i >> 1] = (rv[i - 1] >> 16) | (rv[i] & 0xffff0000u); }
                else { kprev0 = kw0; kprev1 = kw1; }
            }
            *(LAS u32x4*)(KTW + ((2 * dp) * TST + 8 * rg) * 2) = (u32x4){ktw0[0], ktw0[1], ktw0[2], ktw0[3]};
            *(LAS u32x4*)(KTW + ((2 * dp + 1) * TST + 8 * rg) * 2) = (u32x4){ktw1[0], ktw1[1], ktw1[2], ktw1[3]};
            *(LAS u32x4*)(VT + ((2 * dp) * TST + 8 * rg) * 2) = (u32x4){vt0[0], vt0[1], vt0[2], vt0[3]};
            *(LAS u32x4*)(VT + ((2 * dp + 1) * TST + 8 * rg) * 2) = (u32x4){vt1[0], vt1[1], vt1[2], vt1[3]};
        }
        if (cc + 1 < GC) ML_LOAD(c + 1);
        unsigned short so[4][4];
        if (FULL) {
#pragma unroll
            for (int it = 0; it < 4; ++it)
#pragma unroll
                for (int r = 0; r < 4; ++r) so[it][r] = ((const GAS unsigned short*)OML)[(rowbase + t0 + 16 * it + fq4 + r) * 512 + nh * 128 + 16 * wid + fro];
        }
        __syncthreads();
        if (FULL) {
            {
                const int it = wid >> 1, is0 = 2 * (wid & 1);
                f32x4 s0 = (f32x4){0.f, 0.f, 0.f, 0.f}, s1 = s0;
                if (is0 <= it) {
#pragma unroll
                    for (int ks = 0; ks < 4; ++ks) { const bf16x8 a = ldfrag(QS, QST, 16 * it, 32 * ks, oQ); s0 = MFMA16(a, ldfrag(KS, QST, 16 * is0, 32 * ks, oQ), s0);
                        if (is0 + 1 <= it) s1 = MFMA16(a, ldfrag(KS, QST, 16 * (is0 + 1), 32 * ks, oQ), s1); asm volatile("" ::: "memory"); } }
                const float a0 = gsc[GS_A + 16 * is0 + fro], a1 = gsc[GS_A + 16 * is0 + 16 + fro];
#pragma unroll
                for (int r = 0; r < 4; ++r) { const int t = 16 * it + fq4 + r; const float cm = gsc[GS_CM + t]; const int sA = 16 * is0 + fro, sB = sA + 16;
                    const float v0 = sA <= t ? s0[r] * expf(a0 - cm) : 0.f, v1 = sB <= t ? s1[r] * expf(a1 - cm) : 0.f;
                    *(LAS unsigned short*)(SP + (t * TST + sA) * 2) = (unsigned short)f2bf(v0); *(LAS unsigned short*)(SP + (t * TST + sB) * 2) = (unsigned short)f2bf(v1); }
            }
            __syncthreads();
            f32x4 n1[4], n2[4], e1 = (f32x4){0.f, 0.f, 0.f, 0.f}, e2 = e1;
            const bool extra = (wid >= 1 && wid <= 4);
#pragma unroll
            for (int it = 0; it < 4; ++it) { n1[it] = (f32x4){0.f, 0.f, 0.f, 0.f}; n2[it] = n1[it]; }
#pragma unroll
            for (int ks = 0; ks < 2; ++ks) { const bf16x8 bv = ldfrag(VT, TST, 16 * wid, 32 * ks, oT);
#pragma unroll
                for (int it = 0; it < 4; ++it) n1[it] = MFMA16(ldfrag(SP, TST, 16 * it, 32 * ks, oT), bv, n1[it]);
                if (extra) e1 = MFMA16(ldfrag(SP, TST, 16 * (wid - 1), 32 * ks, oT), ldfrag(VT, TST, 128, 32 * ks, oT), e1); asm volatile("" ::: "memory"); }
#pragma unroll
            for (int ks = 0; ks < 4; ++ks) { const bf16x8 bc = ldfrag(CB, CST, 16 * wid, 32 * ks, oQ);
#pragma unroll
                for (int it = 0; it < 4; ++it) n2[it] = MFMA16(ldfrag(QS, QST, 16 * it, 32 * ks, oQ), bc, n2[it]);
                if (extra) e2 = MFMA16(ldfrag(QS, QST, 16 * (wid - 1), 32 * ks, oQ), ldfrag(CB, CST, 128, 32 * ks, oQ), e2); asm volatile("" ::: "memory"); }
            if (extra && fro == 0) {
#pragma unroll
                for (int r = 0; r < 4; ++r) { const int t = 16 * (wid - 1) + fq4 + r; SC[SC_DEN + t] = e1[r] + gsc[GS_INTER + t] * e2[r]; } }
#pragma unroll
            for (int it = 0; it < 4; ++it)
#pragma unroll
                for (int r = 0; r < 4; ++r) { const int t = 16 * it + fq4 + r;
                    const float num = n1[it][r] + gsc[GS_INTER + t] * n2[it][r]; n1[it][r] = num;
                    float sq = num * num; sq += __shfl_xor(sq, 1); sq += __shfl_xor(sq, 2); sq += __shfl_xor(sq, 4); sq += __shfl_xor(sq, 8);
                    if (fro == 0) SC[SC_HSQ + t * 8 + wid] = sq; }
            __syncthreads();
#pragma unroll
            for (int it = 0; it < 4; ++it)
#pragma unroll
                for (int r = 0; r < 4; ++r) { const int t = 16 * it + fq4 + r;
                    const f32x4 pa = *(const LAS f32x4*)(SC + SC_HSQ + t * 8), pb = *(const LAS f32x4*)(SC + SC_HSQ + t * 8 + 4);
                    const float ssum = ((pa[0] + pa[1]) + (pa[2] + pa[3])) + ((pb[0] + pb[1]) + (pb[2] + pb[3]));
                    const float dn = fmaxf(fabsf(SC[SC_DEN + t]), gsc[GS_EMT + t]);
                    const float y = n1[it][r] * (1.0f / sqrtf(ssum * (1.0f / 128.0f) + RMS_EPS * dn * dn)) * gh * __uint_as_float((unsigned)so[it][r] << 16);
                    ((GAS unsigned short*)YML)[(rowbase + t0 + t) * 512 + nh * 128 + 16 * wid + fro] = (unsigned short)f2bf(y); }
        }
        if (!FULL || cc + 1 < GC) {
            const float decay = gsc[GS_INTER + 63];
#pragma unroll
            for (int i = 0; i < 9; ++i) Cacc[i] = Cacc[i] * decay;
#pragma unroll
            for (int ks = 0; ks < 2; ++ks) { const bf16x8 bk8 = ldfrag(KTW, TST, 16 * wid, 32 * ks, oT);
#pragma unroll
                for (int i = 0; i < 9; ++i) Cacc[i] = MFMA16(ldfrag(VT, TST, 16 * i, 32 * ks, oT), bk8, Cacc[i]); asm volatile("" ::: "memory"); }
            if (FULL) {
#pragma unroll
                for (int i = 0; i < 9; ++i)
#pragma unroll
                    for (int r = 0; r < 4; ++r) *(LAS unsigned short*)(CB + ((16 * i + fq4 + r) * CST + 16 * wid + fro) * 2) = (unsigned short)f2bf(Cacc[i][r]);
            }
        }
    }
    if (!FULL) {
        GAS f32x4* dst = (GAS f32x4*)(ws + WS_SUMM + (size_t)(chainid * NG + g) * SUMM_BYTES) + (size_t)wid * 9 * 64 + lane;
#pragma unroll
        for (int i = 0; i < 9; ++i) dst[i * 64] = Cacc[i];
        if (tid == 0) { SUMS[(chainid * NG + g) * 2] = SC[SC_MP + GC]; SUMS[(chainid * NG + g) * 2 + 1] = SC[SC_MP + GC + 1]; }
    }
    __syncthreads();
#undef ML_LOAD
}
#undef MFMA16
}

__device__ __forceinline__ int wg_dequeue(Frame& F, gu32* head) {
    if (F.tid == 0) F.MISC[16] = __hip_atomic_fetch_add(head, 1u, RLX_AGENT);
    __syncthreads();
    const int v = (int)F.MISC[16];
    __syncthreads();
    return v;
}

#ifndef MK_SB_SPLIT
#define MK_SB_SPLIT 384
#endif
template <bool SECOND> __device__ __forceinline__ void mixer_phase(Frame& F, const Ptrs& P, gu32* qhead) {
    unsigned char* ws = P.ws;
    const int item = (int)blockIdx.x;
    for (int it = item; it < BATCH * MLH * mlst::NG; it += (int)gridDim.x) {
        if (SECOND) mlst::item<true>(it / mlst::NG, it % mlst::NG, P, F.lds + RING_OFF); else mlst::item<false>(it / mlst::NG, it % mlst::NG, P, F.lds + RING_OFF); }
    const int ubase = SECOND ? MK_SB_SPLIT : 0, lim = SECOND ? BATCH * SBH * 16 : MK_SB_SPLIT;
    for (;;) {
        const int u = ubase + wg_dequeue(F, qhead + (SECOND ? 32 : 0));
        if (u >= lim) break;
        const int qb = 15 - (u >> 6), bh = u & 63;
        sbat::sb_unit(bh >> 3, bh & 7, qb, (const bf16*)(ws + WS_QSB), (const bf16*)(ws + WS_KSB), (const bf16*)(ws + WS_VSB), (bf16*)(ws + WS_YSB), F.lds + RING_OFF);
    }
}
#ifndef MK_PH_HI
#define MK_PH_HI 12
#endif
#ifndef MK_PER_PHASE
#define MK_PER_PHASE 0
#endif
constexpr int N_PHASES = 12;
struct Args { const float* in[21]; float* out; unsigned char* ws; int ph_lo, ph_hi, li, pad; };

__global__ void __launch_bounds__(NWAVES * 64, 2) mk_fwd(Args args) {
    extern __shared__ __attribute__((aligned(16))) unsigned char lds[];
    Frame F;
    F.lds = (LAS unsigned char*)lds;
    F.MISC = (volatile LAS unsigned*)(F.lds + MISC_OFF);
    F.tid = threadIdx.x; F.lane = F.tid & 63; F.wave = __builtin_amdgcn_readfirstlane(F.tid >> 6);
    F.G = gridDim.x; { const int bx = blockIdx.x; F.vcu = (F.G % 8 == 0) ? (bx % 8) * (F.G / 8) + bx / 8 : bx; }
    unsigned char* ws = args.ws;
    F.ctl = (gu32*)(ws + WS_CTL);
    Ptrs P;
    P.x = args.in[0]; P.p = args.in[1]; P.g_mix_pre = args.in[2]; P.w_in = args.in[3]; P.b_ig = args.in[4]; P.b_fg = args.in[5]; P.w_conv = args.in[6]; P.b_conv = args.in[7];
    P.g_head = args.in[8]; P.w_bsb = args.in[9]; P.w_bml = args.in[10]; P.w_out = args.in[11]; P.g_mix_post = args.in[12]; P.g_mlp_pre = args.in[13]; P.w_up = args.in[14]; P.w_dn = args.in[15];
    P.g_mlp_post = args.in[16]; P.g_ple_pre = args.in[17]; P.w_gate = args.in[18]; P.w_proj = args.in[19]; P.g_ple_post = args.in[20]; P.out = args.out; P.ws = ws;
    if (F.tid < 64) F.MISC[F.tid] = 0u;
    __syncthreads();
    const int lo = args.ph_lo, hi = args.ph_hi;
    XcdBarrier bar; bar.bar = (unsigned*)(F.ctl + CW_BAR) + args.li * XCD_BAR_WORDS; bar.x = 0; bar.st = nullptr;
    if (hi - lo > 1) bar = xcd_barrier_post((unsigned*)(F.ctl + CW_BAR) + args.li * XCD_BAR_WORDS, F.MISC + 8);
#define IN(k) ((k) < MK_PH_HI && lo <= (k) && (k) < hi)
#define SEAM(k) do { if (IN(k) && IN((k) + 1)) xcd_barrier(bar); } while (0)
    bf16* const XN = (bf16*)(ws + WS_XN);
    float* const SSQ = (float*)(ws + WS_SSQ); float* const RS = (float*)(ws + WS_RS);
    unsigned char* const ob = (unsigned char*)args.out;

    if (IN(0)) p0_prologue(F, P);
    SEAM(0);
    if (IN(1)) {
        pg8::Gemm g{XN, (const bf16*)(ws + WS_WIN), M, NIN, DM}; pg8::StaticOrder S; S.init(M, NIN, F.G, (int)blockIdx.x);
        pg8::EpiIn E{(bf16*)(ws + WS_QSB), (bf16*)(ws + WS_KSB), (bf16*)(ws + WS_VSB), (bf16*)(ws + WS_QKML), (bf16*)(ws + WS_VML), (bf16*)(ws + WS_OML), (bf16*)(ob + OUT_GSB), (bf16*)(ob + OUT_GML)};
        pg8::gemm_phase<pg8::EpiIn, pg8::StaticOrder, true, true>(F.lds + RING_OFF, g, S, E);
    }
    SEAM(1);
    if (IN(2)) { mixer_phase<false>(F, P, F.ctl + CW_QUEUE + 64 * args.li); }
    SEAM(2);
    if (IN(3)) { mixer_phase<true>(F, P, F.ctl + CW_QUEUE + 64 * args.li); }
    SEAM(3);
    if (IN(4)) {
        { pg8::Gemm g{(const bf16*)(ws + WS_YSB), (const bf16*)(ws + WS_WBSB), M, DM, 512}; pg8::StaticOrder S; S.init(M, DM, F.G, (int)blockIdx.x);
          pg8::EpiBranch<false> E{(bf16*)(ws + WS_MERGED), (const bf16*)(ob + OUT_GSB)};
          pg8::gemm_phase<pg8::EpiBranch<false>, pg8::StaticOrder, true, true>(F.lds + RING_OFF, g, S, E); }
        { pg8::Gemm g{(const bf16*)(ws + WS_YML), (const bf16*)(ws + WS_WBML), M, DM, 512}; pg8::StaticOrder S; S.init(M, DM, F.G, (int)blockIdx.x);
          pg8::EpiBranch<true> E{(bf16*)(ws + WS_MERGED), (const bf16*)(ob + OUT_GML)};
          pg8::gemm_phase<pg8::EpiBranch<true>, pg8::StaticOrder, true, true>(F.lds + RING_OFF, g, S, E); }
    }
    SEAM(4);
    if (IN(5)) {
        pg8::Gemm g{(const bf16*)(ws + WS_MERGED), (const bf16*)(ws + WS_WOUT), M, DM, DM}; pg8::StaticOrder S; S.init(M, DM, F.G, (int)blockIdx.x);
        pg8::EpiYssq E{(bf16*)(ws + WS_Y1), SSQ};
        pg8::gemm_phase<pg8::EpiYssq, pg8::StaticOrder, true, true>(F.lds + RING_OFF, g, S, E);
    }
    SEAM(5);
    if (IN(6)) ew_residual<true>(F, P.x, (const bf16*)(ws + WS_Y1), SSQ, P.g_mix_post, XN, RS);
    SEAM(6);
    if (IN(7)) {
        pg8::Gemm g{XN, (const bf16*)(ws + WS_WUP), M, FF, DM}; pg8::StaticOrder S; S.init(M, FF, F.G, (int)blockIdx.x);
        pg8::EpiUp E{(bf16*)(ws + WS_H), RS};
        pg8::gemm_phase<pg8::EpiUp, pg8::StaticOrder, true, true>(F.lds + RING_OFF, g, S, E);
    }
    SEAM(7);
    if (IN(8)) {
        pg8::Gemm g{(const bf16*)(ws + WS_H), (const bf16*)(ws + WS_WDN), M, DM, FF}; pg8::StaticOrder S; S.init(M, DM, F.G, (int)blockIdx.x);
        pg8::EpiYssq E{(bf16*)(ob + OUT_Y2), SSQ};
        pg8::gemm_phase<pg8::EpiYssq, pg8::StaticOrder, true, true>(F.lds + RING_OFF, g, S, E);
    }
    SEAM(8);
    if (IN(9)) ew_residual<false>(F, nullptr, (const bf16*)(ob + OUT_Y2), SSQ, P.g_mlp_post, XN, RS);
    SEAM(9);
    if (IN(10)) {
        { int kp = PLE; asm volatile("" : "+s"(kp));
          pg8::Gemm g{(const bf16*)(ws + WS_PB), (const bf16*)(ws + WS_WPROJ), M, DM, kp}; pg8::StaticOrder S; S.init(M, DM, F.G, (int)blockIdx.x);
          pg8::EpiPlain E{(bf16*)(ws + WS_PP)};
          pg8::gemm_phase<pg8::EpiPlain, pg8::StaticOrder, true, true>(F.lds + RING_OFF, g, S, E); }
        { pg8::Gemm g{XN, (const bf16*)(ws + WS_WGATE), M, DM, DM}; pg8::StaticOrder S; S.init(M, DM, F.G, (int)blockIdx.x);
          pg8::EpiPle E{(bf16*)(ws + WS_T), (const bf16*)(ws + WS_PP), RS, SSQ};
          pg8::gemm_phase<pg8::EpiPle, pg8::StaticOrder, true, true>(F.lds + RING_OFF, g, S, E); }
    }
    SEAM(10);
    if (IN(11)) ew_final(F, XN, (const bf16*)(ws + WS_T), SSQ, P.g_ple_post, args.out);
#undef IN
#undef SEAM
}

#if defined(MK_DEBUG)
static void debug_tail(void* const* d_in, float* d_out, unsigned char* d_ws, hipStream_t stream);
#endif
extern "C" void kernel_launch(void* const* d_in, const int* in_sizes, int n_in, void* d_out, int out_size, void* d_ws, size_t ws_size, hipStream_t stream) {
    static int grid = 0;
    if (grid == 0) {
        if (n_in != 21 || in_sizes[0] != M * DM || out_size != M * DM || ws_size < WS_END) { fprintf(stderr, "kernel_launch: unexpected shapes (n_in %d, in0 %d, out %d, ws %zu); nothing launched\n", n_in, n_in > 0 ? in_sizes[0] : -1, out_size, ws_size); grid = -1; return; }
        int dev = 0, cus = 0, per_cu = 0;
        if (hipGetDevice(&dev) != hipSuccess || hipDeviceGetAttribute(&cus, hipDeviceAttributeMultiprocessorCount, dev) != hipSuccess) { grid = -1; return; }
        if (hipFuncSetAttribute((const void*)mk_fwd, hipFuncAttributeMaxDynamicSharedMemorySize, LDS_BYTES) != hipSuccess) { fprintf(stderr, "kernel_launch: hipFuncSetAttribute failed\n"); grid = -1; return; }
        if (hipOccupancyMaxActiveBlocksPerMultiprocessor(&per_cu, (const void*)mk_fwd, NWAVES * 64, LDS_BYTES) != hipSuccess || per_cu < 1)
            fprintf(stderr, "kernel_launch: note: occupancy query reports %d workgroups per CU\n", per_cu);
        (void)hipGetLastError();
        grid = cus;
    }
    if (grid < 0) return;
    if (hipMemsetAsync((char*)d_ws + WS_CTL, 0, CTL_ZERO_BYTES, stream) != hipSuccess) { fprintf(stderr, "kernel_launch: hipMemsetAsync failed\n"); return; }
    Args a{};
    for (int i = 0; i < 21; ++i) a.in[i] = (const float*)d_in[i];
    a.out = (float*)d_out; a.ws = (unsigned char*)d_ws;
#if MK_PER_PHASE
    for (int ph = 0; ph < MK_PH_HI; ++ph) { a.ph_lo = ph; a.ph_hi = ph + 1; hipLaunchKernelGGL(mk_fwd, dim3(grid), dim3(NWAVES * 64), LDS_BYTES, stream, a); }
#elif defined(MK_SPLIT_AT)
    a.ph_lo = 0; a.ph_hi = MK_SPLIT_AT + 1; a.li = 0; hipLaunchKernelGGL(mk_fwd, dim3(grid), dim3(NWAVES * 64), LDS_BYTES, stream, a);
    a.ph_lo = MK_SPLIT_AT; a.ph_hi = MK_PH_HI; a.li = 1; hipLaunchKernelGGL(mk_fwd, dim3(grid), dim3(NWAVES * 64), LDS_BYTES, stream, a);
#else
    a.ph_lo = 0; a.ph_hi = MK_PH_HI;
    hipLaunchKernelGGL(mk_fwd, dim3(grid), dim3(NWAVES * 64), LDS_BYTES, stream, a);
#endif
    const hipError_t le = hipPeekAtLastError();
    if (le != hipSuccess) fprintf(stderr, "kernel_launch: launch failed: %s\n", hipGetErrorName(le));
#if defined(MK_DEBUG)
    debug_tail(d_in, (float*)d_out, (unsigned char*)d_ws, stream);
#endif
}
```
